# Optimizing an MI355X kernel written in HIP

```python
import math
import jax
import jax.numpy as jnp
from jax import lax
import numpy as np

D_MODEL = 1024
BATCH = 2
SEQ = 8192
DEPTH = 2

MEM_LEN = 256
N_BRANCH = 4
BRANCH_WIDTH = 256
BLOCK_Q = 128
EPS = 1e-5
MAX_POS_OFFSET = 4096
NEG_BIG = -1e30

MLA_HEADS = 4
MLA_Q_LORA = 256
MLA_KV_LORA = 128
MLA_NOPE = 64
MLA_ROPE = 32
MLA_V = 64
ROPE_THETA = 10000.0

SWA_HEADS = 4
SWA_KV_HEADS = 2
SWA_HEAD_DIM = 64
SWA_WINDOW = 128

HGRN_HEADS = 4
HGRN_DK = 64
HGRN_DV = 64
HGRN_CHUNK = 64

SB_HEADS = 4
SB_HEAD_DIM = 64

REL_BUCKETS = 32
REL_MAX_DIST = 128

XA_HEADS = 4
XA_HEAD_DIM = 64

F_DENSE = 2816
N_EXPERTS = 8
TOP_K = 2
F_EXPERT = 3584
MOE_BLOCK = 256

DEEPNORM_ALPHA = (2 * DEPTH) ** 0.25
DEEPNORM_BETA = (8 * DEPTH) ** -0.25
N_DENSE = (DEPTH + 1) // 2
N_MOE = DEPTH // 2

IN_SPLITS = (
    ('mla_cq', MLA_Q_LORA),
    ('mla_ckv', MLA_KV_LORA),
    ('mla_kr', MLA_ROPE),
    ('swa_q', SWA_HEADS * SWA_HEAD_DIM),
    ('swa_k', SWA_KV_HEADS * SWA_HEAD_DIM),
    ('swa_v', SWA_KV_HEADS * SWA_HEAD_DIM),
    ('hgrn_q', HGRN_HEADS * HGRN_DK),
    ('hgrn_f', HGRN_HEADS * HGRN_DK),
    ('hgrn_i', HGRN_HEADS * HGRN_DV),
    ('hgrn_g', HGRN_HEADS * HGRN_DV),
    ('sb_q', SB_HEADS * SB_HEAD_DIM),
    ('sb_k', SB_HEADS * SB_HEAD_DIM),
    ('sb_v', SB_HEADS * SB_HEAD_DIM),
    ('gates', N_BRANCH * D_MODEL),
)
IN_COLS = sum(width for _, width in IN_SPLITS)

kernel_name = 'hybrid_mla_swa_hgrn2_stickbreak_moe_block'

F32 = jnp.float32


def _split_cols(h):
    out = {}
    off = 0
    for name, width in IN_SPLITS:
        out[name] = h[..., off:off + width]
        off += width
    return out


def _layernorm(x, g, b):
    xf = x.astype(F32)
    mu = jnp.mean(xf, axis=-1, keepdims=True)
    xc = xf - mu
    var = jnp.mean(xc * xc, axis=-1, keepdims=True)
    return (xc * lax.rsqrt(var + EPS) * g.astype(F32) + b.astype(F32)).astype(x.dtype)


def _rmsnorm(x, g):
    xf = x.astype(F32)
    return (xf * lax.rsqrt(jnp.mean(xf * xf, axis=-1, keepdims=True) + EPS) * g.astype(F32)).astype(x.dtype)


def _rope(x, positions):
    half = x.shape[-1] // 2
    inv_freq = ROPE_THETA ** (-jnp.arange(half, dtype=F32) / half)
    ang = positions.astype(F32)[..., None] * inv_freq
    ang = ang.reshape(ang.shape[:2] + (1,) * (x.ndim - 3) + (half,))
    cos, sin = jnp.cos(ang), jnp.sin(ang)
    x1, x2 = x[..., :half].astype(F32), x[..., half:].astype(F32)
    return jnp.concatenate([x1 * cos - x2 * sin, x1 * sin + x2 * cos], axis=-1).astype(x.dtype)


def _to_qblocks(t):
    b, s = t.shape[:2]
    return jnp.moveaxis(t.reshape((b, s // BLOCK_Q, BLOCK_Q) + t.shape[2:]), 1, 0)


def _from_qblocks(t):
    t = jnp.moveaxis(t, 0, 1)
    return t.reshape((t.shape[0], t.shape[1] * t.shape[2]) + t.shape[3:])


def _rel_bucket(dist):
    exact = REL_BUCKETS // 2
    n = jnp.maximum(dist, 0)
    nf = jnp.maximum(n, 1).astype(F32)
    large = exact + (jnp.log(nf / exact) / math.log(REL_MAX_DIST / exact) * (REL_BUCKETS - exact)).astype(jnp.int32)
    large = jnp.clip(large, 0, REL_BUCKETS - 1)
    return jnp.where(n < exact, n, large)


def _mla(cq, ckv, kr, positions, q_norm, w_uq, kv_norm, w_ukv):
    b, s, _ = cq.shape
    q = (_rmsnorm(cq, q_norm) @ w_uq).reshape(b, s, MLA_HEADS, MLA_NOPE + MLA_ROPE)
    q_nope = q[..., :MLA_NOPE]
    q_rope = _rope(q[..., MLA_NOPE:], positions)
    kv = (_rmsnorm(ckv, kv_norm) @ w_ukv).reshape(b, s, MLA_HEADS, MLA_NOPE + MLA_V)
    k_nope, v = kv[..., :MLA_NOPE], kv[..., MLA_NOPE:]
    k_rope = _rope(kr, positions)
    scale = (MLA_NOPE + MLA_ROPE) ** -0.5
    k_idx = jnp.arange(s)

    def block(args):
        qn, qr, q_idx = args
        logits = (jnp.einsum('bqhd,bkhd->bhqk', qn, k_nope).astype(F32)
                  + jnp.einsum('bqhr,bkr->bhqk', qr, k_rope).astype(F32)) * scale
        causal = k_idx[None, :] <= q_idx[:, None]
        logits = jnp.where(causal[None, None], logits, NEG_BIG)
        p = jax.nn.softmax(logits, axis=-1).astype(v.dtype)
        return jnp.einsum('bhqk,bkhd->bqhd', p, v)

    o = lax.map(block, (_to_qblocks(q_nope), _to_qblocks(q_rope), k_idx.reshape(-1, BLOCK_Q)))
    return _from_qblocks(o).reshape(b, s, MLA_HEADS * MLA_V)


def _swa(q, k, v, positions, sinks, rel_table):
    b, s, _ = q.shape
    w = SWA_WINDOW
    nb = s // w
    g = SWA_HEADS // SWA_KV_HEADS
    qb = q.reshape(b, nb, w, SWA_KV_HEADS, g, SWA_HEAD_DIM)

    def band(t):
        tb = t.reshape((b, nb, w) + t.shape[2:])
        prev = jnp.concatenate([jnp.zeros_like(tb[:, :1]), tb[:, :-1]], axis=1)
        return jnp.concatenate([prev, tb], axis=2)

    kb = band(k.reshape(b, s, SWA_KV_HEADS, SWA_HEAD_DIM))
    vb = band(v.reshape(b, s, SWA_KV_HEADS, SWA_HEAD_DIM))
    pq = positions.reshape(b, nb, w)
    pk = band(positions)
    logits = jnp.einsum('bnqhgd,bnkhd->bnhgqk', qb, kb).astype(F32) * SWA_HEAD_DIM ** -0.5
    bucket = _rel_bucket(pq[..., :, None] - pk[..., None, :])
    bias = jnp.moveaxis(rel_table[bucket].astype(F32), -1, 2)
    logits = logits + bias.reshape(b, nb, SWA_KV_HEADS, g, w, 2 * w)
    i = jnp.arange(w)[:, None]
    j = jnp.arange(2 * w)[None, :]
    in_window = (j >= i + 1) & (j <= i + w)
    valid = in_window[None] & ((jnp.arange(nb)[:, None, None] > 0) | (j >= w)[None])
    logits = jnp.where(valid[None, :, None, None], logits, NEG_BIG)
    sink = sinks.astype(F32).reshape(1, 1, SWA_KV_HEADS, g, 1, 1)
    m = jnp.maximum(jnp.max(logits, axis=-1, keepdims=True), sink)
    p = jnp.exp(logits - m)
    p = p / (jnp.sum(p, axis=-1, keepdims=True) + jnp.exp(sink - m))
    o = jnp.einsum('bnhgqk,bnkhd->bnqhgd', p.astype(v.dtype), vb)
    return o.reshape(b, s, SWA_HEADS * SWA_HEAD_DIM)


def _hgrn2(q, f, i, g, lower_bound, norm_w):
    dt = g.dtype
    b, s, _ = q.shape
    c = HGRN_CHUNK
    nc = s // c
    qf = jax.nn.silu(q.astype(F32))
    lb = lower_bound.astype(F32)
    forget = lb + (1.0 - lb) * jax.nn.sigmoid(f.astype(F32))
    log_f = jnp.log(forget)
    kf = 1.0 - forget
    vf = i.astype(F32)

    def chunks(t, d):
        return t.reshape(b, nc, c, HGRN_HEADS, d).transpose(1, 0, 3, 2, 4)

    causal = jnp.tril(jnp.ones((c, c), dtype=bool))

    def step(state, inp):
        qc, kc, vc, gc = inp
        bc = jnp.cumsum(gc, axis=2)
        o_inter = jnp.einsum('bhtk,bhkv->bhtv', qc * jnp.exp(bc), state)
        diff = bc[:, :, :, None, :] - bc[:, :, None, :, :]
        decay = jnp.exp(jnp.where(causal[:, :, None], diff, NEG_BIG))
        att = jnp.einsum('bhtk,bhtsk,bhsk->bhts', qc, decay, kc)
        o = o_inter + jnp.einsum('bhts,bhsv->bhtv', att, vc)
        b_last = bc[:, :, -1:, :]
        state = (jnp.exp(b_last[:, :, 0, :, None]) * state
                 + jnp.einsum('bhsk,bhsv->bhkv', kc * jnp.exp(b_last - bc), vc))
        return state, o

    s0 = jnp.zeros((b, HGRN_HEADS, HGRN_DK, HGRN_DV), F32)
    _, o = lax.scan(step, s0, (chunks(qf, HGRN_DK), chunks(kf, HGRN_DK), chunks(vf, HGRN_DV), chunks(log_f, HGRN_DK)))
    o = o.transpose(1, 0, 3, 2, 4).reshape(b, s, HGRN_HEADS, HGRN_DV)
    gate = jax.nn.silu(g.astype(F32).reshape(b, s, HGRN_HEADS, HGRN_DV))
    o = _rmsnorm(o, norm_w.reshape(HGRN_HEADS, HGRN_DV)) * gate
    return o.reshape(b, s, HGRN_HEADS * HGRN_DV).astype(dt)


def _stick_breaking(q, k, v):
    b, s, _ = q.shape
    q = q.reshape(b, s, SB_HEADS, SB_HEAD_DIM)
    k = k.reshape(b, s, SB_HEADS, SB_HEAD_DIM)
    v = v.reshape(b, s, SB_HEADS, SB_HEAD_DIM)
    k_idx = jnp.arange(s)

    def block(args):
        qb, q_idx = args
        z = jnp.einsum('bqhd,bkhd->bhqk', qb, k).astype(F32) * SB_HEAD_DIM ** -0.5
        strict = (k_idx[None, :] < q_idx[:, None])[None, None]
        log_1m_beta = jnp.where(strict, jax.nn.log_sigmoid(-z), 0.0)
        log_remain = lax.cumsum(log_1m_beta, axis=3, reverse=True) - log_1m_beta
        a = jnp.where(strict, jnp.exp(jax.nn.log_sigmoid(z) + log_remain), 0.0)
        return jnp.einsum('bhqk,bkhd->bqhd', a.astype(v.dtype), v)

    o = lax.map(block, (_to_qblocks(q), k_idx.reshape(-1, BLOCK_Q)))
    return _from_qblocks(o).reshape(b, s, SB_HEADS * SB_HEAD_DIM)


def _hybrid_mixer(x, positions, lower_bound, rel_table, w_in, mla_q_norm, mla_w_uq, mla_kv_norm,
                  mla_w_ukv, swa_sinks, hgrn_norm, w_branch, w_out):
    b, s, _ = x.shape
    p = _split_cols(x @ w_in)
    y_mla = _mla(p['mla_cq'], p['mla_ckv'], p['mla_kr'], positions, mla_q_norm, mla_w_uq, mla_kv_norm, mla_w_ukv)
    y_swa = _swa(p['swa_q'], p['swa_k'], p['swa_v'], positions, swa_sinks, rel_table)
    y_hgrn = _hgrn2(p['hgrn_q'], p['hgrn_f'], p['hgrn_i'], p['hgrn_g'], lower_bound, hgrn_norm)
    y_sb = _stick_breaking(p['sb_q'], p['sb_k'], p['sb_v'])
    branches = jnp.stack([y_mla, y_swa, y_hgrn, y_sb], axis=2)
    gates = jax.nn.sigmoid(p['gates'].reshape(b, s, N_BRANCH, D_MODEL))
    merged = jnp.sum(gates * jnp.einsum('bsnc,ncd->bsnd', branches, w_branch), axis=2)
    return merged @ w_out


def _mem_xattn(x, mem, wq, wkv, wo):
    b, s, _ = x.shape
    m = mem.shape[1]
    q = (x @ wq).reshape(b, s, XA_HEADS, XA_HEAD_DIM)
    kv = (mem @ wkv).reshape(b, m, 2, XA_HEADS, XA_HEAD_DIM)
    k, v = kv[:, :, 0], kv[:, :, 1]
    logits = jnp.einsum('bshd,bmhd->bhsm', q, k).astype(F32) * XA_HEAD_DIM ** -0.5
    p = jax.nn.softmax(logits, axis=-1).astype(v.dtype)
    o = jnp.einsum('bhsm,bmhd->bshd', p, v).reshape(b, s, XA_HEADS * XA_HEAD_DIM)
    return o @ wo


def _swiglu(x, w13, w2):
    a, gate = jnp.split(x @ w13, 2, axis=-1)
    return (jax.nn.silu(a) * gate) @ w2


def _moe(x, router, w13, w2):
    b, s, d = x.shape
    n = b * s
    a = n * TOP_K
    xf = x.reshape(n, d)
    logits = (xf @ router).astype(F32)
    top_val, top_idx = lax.top_k(logits, TOP_K)
    top_w = jax.nn.softmax(top_val, axis=-1)
    e_flat = top_idx.reshape(-1)
    t_flat = jnp.repeat(jnp.arange(n, dtype=jnp.int32), TOP_K)
    w_flat = top_w.reshape(-1)
    order = jnp.argsort(e_flat)
    e_s, t_s, w_s = e_flat[order], t_flat[order], w_flat[order]
    counts = jnp.bincount(e_flat, length=N_EXPERTS)
    padded = (counts + MOE_BLOCK - 1) // MOE_BLOCK * MOE_BLOCK
    group_start = jnp.cumsum(counts) - counts
    padded_end = jnp.cumsum(padded)
    padded_start = padded_end - padded
    dest = padded_start[e_s] + jnp.arange(a, dtype=jnp.int32) - group_start[e_s]
    cap = a + N_EXPERTS * MOE_BLOCK
    n_blk = cap // MOE_BLOCK
    slot_tok = jnp.full((cap,), n, dtype=jnp.int32).at[dest].set(t_s)
    slot_w = jnp.zeros((cap,), F32).at[dest].set(w_s)
    blk_exp = jnp.minimum(jnp.searchsorted(padded_end, jnp.arange(n_blk) * MOE_BLOCK, side='right'), N_EXPERTS - 1)
    x_pad = jnp.concatenate([xf, jnp.zeros((1, d), x.dtype)], axis=0)
    xb = x_pad[slot_tok].reshape(n_blk, MOE_BLOCK, d)

    def expert_block(args):
        xe, e = args
        return _swiglu(xe, w13[e], w2[e])

    yb = lax.map(expert_block, (xb, blk_exp)).reshape(cap, d)
    y = jnp.zeros((n + 1, d), x.dtype).at[slot_tok].add(yb * slot_w[:, None].astype(x.dtype))
    return y[:n].reshape(b, s, d)


def setup_inputs(seed: int = 0) -> dict:
    key = jax.random.key(seed)
    ks = list(jax.random.split(key, 24))

    def nrm(k, shape, scale):
        return jax.random.normal(k, shape, F32) * scale

    x = nrm(ks[0], (BATCH, SEQ, D_MODEL), 1.0)
    mem = nrm(ks[1], (BATCH, MEM_LEN, D_MODEL), 1.0)
    offset = jax.random.randint(ks[2], (BATCH, 1), 0, MAX_POS_OFFSET, dtype=jnp.int32)
    positions = (offset + jnp.arange(SEQ, dtype=jnp.int32)[None, :]).astype(jnp.int32)
    rel_bias_table = nrm(ks[3], (REL_BUCKETS, SWA_HEADS), 0.5)
    hgrn_lb_logits = nrm(ks[4], (DEPTH, HGRN_HEADS * HGRN_DK), 0.5)
    w_in = nrm(ks[5], (DEPTH, D_MODEL, IN_COLS), D_MODEL ** -0.5)
    mla_q_norm = 1.0 + nrm(ks[6], (DEPTH, MLA_Q_LORA), 0.02)
    mla_w_uq = nrm(ks[7], (DEPTH, MLA_Q_LORA, MLA_HEADS * (MLA_NOPE + MLA_ROPE)), MLA_Q_LORA ** -0.5)
    mla_kv_norm = 1.0 + nrm(ks[8], (DEPTH, MLA_KV_LORA), 0.02)
    mla_w_ukv = nrm(ks[9], (DEPTH, MLA_KV_LORA, MLA_HEADS * (MLA_NOPE + MLA_V)), MLA_KV_LORA ** -0.5)
    swa_sinks = nrm(ks[10], (DEPTH, SWA_HEADS), 1.0)
    hgrn_norm = 1.0 + nrm(ks[11], (DEPTH, HGRN_HEADS * HGRN_DV), 0.02)
    w_branch = nrm(ks[12], (DEPTH, N_BRANCH, BRANCH_WIDTH, D_MODEL), BRANCH_WIDTH ** -0.5)
    w_out = nrm(ks[13], (DEPTH, D_MODEL, D_MODEL), D_MODEL ** -0.5 * DEEPNORM_BETA)
    ln_g = 1.0 + nrm(ks[14], (DEPTH, 3, D_MODEL), 0.02)
    ln_b = nrm(ks[15], (DEPTH, 3, D_MODEL), 0.02)
    xa_wq = nrm(ks[16], (DEPTH, D_MODEL, XA_HEADS * XA_HEAD_DIM), D_MODEL ** -0.5)
    xa_wkv = nrm(ks[17], (DEPTH, D_MODEL, 2 * XA_HEADS * XA_HEAD_DIM), D_MODEL ** -0.5)
    xa_wo = nrm(ks[18], (DEPTH, XA_HEADS * XA_HEAD_DIM, D_MODEL), (XA_HEADS * XA_HEAD_DIM) ** -0.5 * DEEPNORM_BETA)
    ffn_w13 = nrm(ks[19], (N_DENSE, D_MODEL, 2 * F_DENSE), D_MODEL ** -0.5)
    ffn_w2 = nrm(ks[20], (N_DENSE, F_DENSE, D_MODEL), F_DENSE ** -0.5 * DEEPNORM_BETA)
    moe_router = nrm(ks[21], (N_MOE, D_MODEL, N_EXPERTS), D_MODEL ** -0.5)
    moe_w13 = nrm(ks[22], (N_MOE, N_EXPERTS, D_MODEL, 2 * F_EXPERT), D_MODEL ** -0.5)
    moe_w2 = nrm(ks[23], (N_MOE, N_EXPERTS, F_EXPERT, D_MODEL), F_EXPERT ** -0.5 * DEEPNORM_BETA)
    return {'x': x, 'mem': mem, 'positions': positions, 'rel_bias_table': rel_bias_table,
            'hgrn_lb_logits': hgrn_lb_logits, 'w_in': w_in, 'mla_q_norm': mla_q_norm, 'mla_w_uq': mla_w_uq,
            'mla_kv_norm': mla_kv_norm, 'mla_w_ukv': mla_w_ukv, 'swa_sinks': swa_sinks, 'hgrn_norm': hgrn_norm,
            'w_branch': w_branch, 'w_out': w_out, 'ln_g': ln_g, 'ln_b': ln_b, 'xa_wq': xa_wq, 'xa_wkv': xa_wkv,
            'xa_wo': xa_wo, 'ffn_w13': ffn_w13, 'ffn_w2': ffn_w2, 'moe_router': moe_router,
            'moe_w13': moe_w13, 'moe_w2': moe_w2}


def reference(x, mem, positions, rel_bias_table, hgrn_lb_logits, w_in, mla_q_norm, mla_w_uq, mla_kv_norm,
              mla_w_ukv, swa_sinks, hgrn_norm, w_branch, w_out, ln_g, ln_b, xa_wq, xa_wkv, xa_wo,
              ffn_w13, ffn_w2, moe_router, moe_w13, moe_w2):
    sm = jax.nn.softmax(hgrn_lb_logits.astype(F32), axis=0)
    lower_bounds = jnp.cumsum(sm, axis=0) - sm[0]
    for l in range(DEPTH):
        y = _hybrid_mixer(x, positions, lower_bounds[l], rel_bias_table, w_in[l], mla_q_norm[l], mla_w_uq[l],
                          mla_kv_norm[l], mla_w_ukv[l], swa_sinks[l], hgrn_norm[l], w_branch[l], w_out[l])
        x = _layernorm(DEEPNORM_ALPHA * x + y, ln_g[l, 0], ln_b[l, 0])
        y = _mem_xattn(x, mem, xa_wq[l], xa_wkv[l], xa_wo[l])
        x = _layernorm(DEEPNORM_ALPHA * x + y, ln_g[l, 1], ln_b[l, 1])
        if l % 2 == 0:
            y = _swiglu(x, ffn_w13[l // 2], ffn_w2[l // 2])
        else:
            y = _moe(x, moe_router[l // 2], moe_w13[l // 2], moe_w2[l // 2])
        x = _layernorm(DEEPNORM_ALPHA * x + y, ln_g[l, 2], ln_b[l, 2])
    return x
```

```cpp
#include <hip/hip_runtime.h>
#include <hip/hip_cooperative_groups.h>
#include <cstdio>
#include <cstdint>
namespace cg = cooperative_groups;

typedef unsigned short bf16_t;
typedef float f32x4 __attribute__((ext_vector_type(4)));

constexpr int DM = 1024, BATCH = 2, SEQ = 8192, M = BATCH * SEQ, DEPTH = 2, MEMLEN = 256;
constexpr int IN_COLS = 6816;
constexpr int C_CQ = 0, C_CKV = 256, C_KR = 384, C_SWQ = 416, C_SWK = 672, C_SWV = 800, C_HQ = 928, C_HF = 1184, C_HI = 1440, C_HG = 1696,
              C_SBQ = 1952, C_SBK = 2208, C_SBV = 2464, C_GATE = 2720;
constexpr int F_DENSE = 2816, F_EXP = 3584, NEXP = 8;
constexpr int CAP = 2 * M + NEXP * 256;
constexpr float EPS = 1e-5f;
constexpr float ALPHA = 1.4142135623730951f;
constexpr int NT = 512;

constexpr size_t MiB = 1u << 20;
constexpr size_t WS_CTL = 0;
constexpr size_t WS_X = 1 * MiB;
constexpr size_t WS_T = WS_X + 64 * MiB;
constexpr size_t WS_Y = WS_T + 64 * MiB;
constexpr size_t WS_MERGED = WS_Y + 64 * MiB;
constexpr size_t WS_QM = WS_MERGED + 64 * MiB;
constexpr size_t WS_KM = WS_QM + 24 * MiB;
constexpr size_t WS_VM = WS_KM + 24 * MiB;
constexpr size_t WS_XQ = WS_VM + 16 * MiB;
constexpr size_t WS_XO = WS_XQ + 16 * MiB;
constexpr size_t WS_KVMEM = WS_XO + 16 * MiB;
constexpr size_t WS_ROUTE = WS_KVMEM + 1 * MiB;
constexpr size_t WS_YS = WS_ROUTE + 4 * MiB;
constexpr size_t WS_BIG = WS_YS + 136 * MiB;
constexpr size_t WS_END = WS_BIG + 240 * MiB;
static_assert(WS_END <= 900 * MiB, "workspace");

constexpr int CW_CNT = 0;
constexpr int CW_UNIT = 64;

struct Params {
  const float* x; const float* mem; const int* pos; const float* rel; const float* lbl; const float* w_in;
  const float* qnorm; const float* w_uq; const float* kvnorm; const float* w_ukv; const float* sinks; const float* hnorm;
  const float* w_branch; const float* w_out; const float* ln_g; const float* ln_b; const float* xa_wq; const float* xa_wkv; const float* xa_wo;
  const float* ffn_w13; const float* ffn_w2; const float* router; const float* moe_w13; const float* moe_w2;
  float* out; unsigned char* ws;
};

__device__ __forceinline__ float bf2f(bf16_t v) { return __uint_as_float((unsigned)v << 16); }
__device__ __forceinline__ bf16_t f2bf(float f) { unsigned u = __float_as_uint(f); return (bf16_t)((u + 0x7fffu + ((u >> 16) & 1u)) >> 16); }
__device__ __forceinline__ float ldf(const float* p, size_t i) { return p[i]; }
__device__ __forceinline__ float ldf(const bf16_t* p, size_t i) { return bf2f(p[i]); }
__device__ __forceinline__ void stf(float* p, size_t i, float v) { p[i] = v; }
__device__ __forceinline__ void stf(bf16_t* p, size_t i, float v) { p[i] = f2bf(v); }
__device__ __forceinline__ float sigmoidf_(float x) { return 1.0f / (1.0f + expf(-x)); }
__device__ __forceinline__ float siluf_(float x) { return x / (1.0f + expf(-x)); }
__device__ __forceinline__ float logsigf_(float z) { return fminf(z, 0.0f) - log1pf(expf(-fabsf(z))); }
__device__ __forceinline__ float wave_sum(float v) {
#pragma unroll
  for (int o = 1; o < 64; o <<= 1) v += __shfl_xor(v, o);
  return v;
}
__device__ __forceinline__ float wave_max(float v) {
#pragma unroll
  for (int o = 1; o < 64; o <<= 1) v = fmaxf(v, __shfl_xor(v, o));
  return v;
}
__device__ __forceinline__ int rel_bucket(int d) {
  int n = d > 0 ? d : 0;
  if (n < 16) return n;
  float nf = (float)n;
  int large = 16 + (int)(logf(nf / 16.0f) / 2.0794415416798357f * 16.0f);
  large = large < 0 ? 0 : (large > 31 ? 31 : large);
  return large;
}
__device__ const float INV_FREQ[16] = {1.0f, 0.5623413251903491f, 0.31622776601683794f, 0.1778279410038923f, 0.1f, 0.05623413251903491f, 0.031622776601683794f,
  0.01778279410038923f, 0.01f, 0.005623413251903491f, 0.0031622776601683794f, 0.001778279410038923f, 0.001f, 0.0005623413251903491f,
  0.00031622776601683794f, 0.0001778279410038923f};
__device__ __forceinline__ void sincos_big(float ang, float& s, float& c) {
  double rev = (double)ang * 0.15915494309189535;
  rev = rev - rint(rev);
  float fr = (float)rev;
  s = __builtin_amdgcn_sinf(fr); c = __builtin_amdgcn_cosf(fr);
}

__device__ __forceinline__ int launder(int v) { asm volatile("" : "+v"(v)); return v; }
#define PHASE_IDS const int tid = launder((int)threadIdx.x), lane = tid & 63, wave = tid >> 6, gw = bid * 8 + wave, ty = tid >> 4, tx = tid & 15; (void)lane; (void)wave; (void)gw; (void)ty; (void)tx;
template <typename TA, bool DUAL>
__device__ __forceinline__ void tile_mm(float (&acc)[4][8], float (&acc2)[4][8], const TA* A, int lda, const int* ridx, int row0,
                                        const float* B, const float* B2, int ldb, int col0, int N, int K, float* sm) {
  float* sA = sm; float* sB = sm + 16 * 132; float* sB2 = sm + 32 * 132;
  const int tid = launder((int)threadIdx.x), ty = tid >> 4, tx = tid & 15;
  const int ar = tid >> 2, ak = (tid & 3) * 4;
  const int bk = tid >> 5, bc = (tid & 31) * 4;
  long arow = ridx ? (long)ridx[row0 + ar] : (long)(row0 + ar);
#pragma unroll
  for (int i = 0; i < 4; ++i)
#pragma unroll
    for (int j = 0; j < 8; ++j) { acc[i][j] = 0.f; acc2[i][j] = 0.f; }
  const bool bval = (col0 + bc) < N;
  for (int k0 = 0; k0 < K; k0 += 16) {
    float a0 = 0.f, a1 = 0.f, a2 = 0.f, a3 = 0.f;
    if (arow >= 0) { const size_t o = (size_t)arow * lda + k0 + ak; a0 = ldf(A, o); a1 = ldf(A, o + 1); a2 = ldf(A, o + 2); a3 = ldf(A, o + 3); }
    f32x4 b = {0.f, 0.f, 0.f, 0.f}, b2 = {0.f, 0.f, 0.f, 0.f};
    if (bval) { b = *(const f32x4*)(B + (size_t)(k0 + bk) * ldb + col0 + bc); if (DUAL) b2 = *(const f32x4*)(B2 + (size_t)(k0 + bk) * ldb + col0 + bc); }
    __syncthreads();
    sA[(ak + 0) * 132 + ar] = a0; sA[(ak + 1) * 132 + ar] = a1; sA[(ak + 2) * 132 + ar] = a2; sA[(ak + 3) * 132 + ar] = a3;
    *(f32x4*)&sB[bk * 132 + bc] = b;
    if (DUAL) *(f32x4*)&sB2[bk * 132 + bc] = b2;
    __syncthreads();
#pragma unroll 4
    for (int kk = 0; kk < 16; ++kk) {
      const f32x4 a = *(const f32x4*)&sA[kk * 132 + ty * 4];
      const f32x4 p = *(const f32x4*)&sB[kk * 132 + tx * 8], q = *(const f32x4*)&sB[kk * 132 + tx * 8 + 4];
#pragma unroll
      for (int i = 0; i < 4; ++i) {
        acc[i][0] += a[i] * p[0]; acc[i][1] += a[i] * p[1]; acc[i][2] += a[i] * p[2]; acc[i][3] += a[i] * p[3];
        acc[i][4] += a[i] * q[0]; acc[i][5] += a[i] * q[1]; acc[i][6] += a[i] * q[2]; acc[i][7] += a[i] * q[3];
      }
      if (DUAL) {
        const f32x4 p2 = *(const f32x4*)&sB2[kk * 132 + tx * 8], q2 = *(const f32x4*)&sB2[kk * 132 + tx * 8 + 4];
#pragma unroll
        for (int i = 0; i < 4; ++i) {
          acc2[i][0] += a[i] * p2[0]; acc2[i][1] += a[i] * p2[1]; acc2[i][2] += a[i] * p2[2]; acc2[i][3] += a[i] * p2[3];
          acc2[i][4] += a[i] * q2[0]; acc2[i][5] += a[i] * q2[1]; acc2[i][6] += a[i] * q2[2]; acc2[i][7] += a[i] * q2[3];
        }
      }
    }
  }
  __syncthreads();
}

__device__ __forceinline__ void ln_rows(const float* T, float* dst, const float* g, const float* b, int gw, int ngw, int lane) {
  for (int r = gw; r < M; r += ngw) {
    const f32x4* tr = (const f32x4*)(T + (size_t)r * DM) + lane;
    f32x4 v[4]; float s = 0.f;
#pragma unroll
    for (int j = 0; j < 4; ++j) { v[j] = tr[64 * j]; s += (v[j][0] + v[j][1]) + (v[j][2] + v[j][3]); }
    const float mean = wave_sum(s) * (1.f / DM); float s2 = 0.f;
#pragma unroll
    for (int j = 0; j < 4; ++j) { v[j] = v[j] - mean; s2 += (v[j][0] * v[j][0] + v[j][1] * v[j][1]) + (v[j][2] * v[j][2] + v[j][3] * v[j][3]); }
    const float rstd = rsqrtf(wave_sum(s2) * (1.f / DM) + EPS);
    f32x4* o = (f32x4*)(dst + (size_t)r * DM) + lane;
#pragma unroll
    for (int j = 0; j < 4; ++j) { const f32x4 gg = ((const f32x4*)g)[lane + 64 * j], bb = ((const f32x4*)b)[lane + 64 * j]; o[64 * j] = v[j] * rstd * gg + bb; }
  }
}

__global__ void __launch_bounds__(NT) mega(Params p) {
  extern __shared__ __attribute__((aligned(16))) unsigned char lds_raw[];
  float* sm = (float*)lds_raw;
  cg::grid_group grid = cg::this_grid();
  const int G = gridDim.x, bid = blockIdx.x, ngw = G * 8;
  unsigned char* ws = p.ws;
  unsigned* ctl = (unsigned*)(ws + WS_CTL);
  float* X = (float*)(ws + WS_X); float* T = (float*)(ws + WS_T); float* Y = (float*)(ws + WS_Y); float* MG = (float*)(ws + WS_MERGED);
  float* QM = (float*)(ws + WS_QM); float* KM = (float*)(ws + WS_KM); float* VM = (float*)(ws + WS_VM);
  float* XQ = (float*)(ws + WS_XQ); float* XO = (float*)(ws + WS_XO); float* KVMEM = (float*)(ws + WS_KVMEM);
  bf16_t* PROJ = (bf16_t*)(ws + WS_BIG); bf16_t* H2 = (bf16_t*)(ws + WS_BIG); float* YS = (float*)(ws + WS_YS);
  int* tok_e = (int*)(ws + WS_ROUTE); int* tok_p = tok_e + 2 * M; float* tok_w = (float*)(tok_p + 2 * M); int* tok_slot = (int*)(tok_w + 2 * M);
  int* slot_tok = tok_slot + 2 * M;
  float acc[4][8], acc2[4][8];

  for (int l = 0; l < DEPTH; ++l) {
    const float* xin = (l == 0) ? p.x : X;
    { PHASE_IDS
      const float* W = p.w_in + (size_t)l * DM * IN_COLS;
      const int ntn = (IN_COLS + 127) / 128, ntiles = (M / 128) * ntn;
      for (int t = bid; t < ntiles; t += G) {
        const int tm = t / ntn, tn = t % ntn;
        tile_mm<float, false>(acc, acc2, xin, DM, nullptr, tm * 128, W, nullptr, IN_COLS, tn * 128, IN_COLS, DM, sm);
#pragma unroll
        for (int i = 0; i < 4; ++i)
#pragma unroll
          for (int j = 0; j < 8; ++j) { const int r = tm * 128 + ty * 4 + i, c = tn * 128 + tx * 8 + j;
            if (c < IN_COLS) { float v = acc[i][j]; if (c >= C_GATE) v = sigmoidf_(v); PROJ[(size_t)r * IN_COLS + c] = f2bf(v); } }
      }
      const float* Wkv = p.xa_wkv + (size_t)l * DM * 512;
      for (int t = bid; t < 4 * 4; t += G) {
        const int tm = t / 4, tn = t % 4;
        tile_mm<float, false>(acc, acc2, p.mem, DM, nullptr, tm * 128, Wkv, nullptr, 512, tn * 128, 512, DM, sm);
#pragma unroll
        for (int i = 0; i < 4; ++i)
#pragma unroll
          for (int j = 0; j < 8; ++j) KVMEM[(size_t)(tm * 128 + ty * 4 + i) * 512 + tn * 128 + tx * 8 + j] = acc[i][j];
      }
    }
    grid.sync();
    { PHASE_IDS
      float* sc = sm + wave * 1024;
      float* sq = sc + 256;
      const float* Wuq = p.w_uq + (size_t)l * 256 * 384; const float* Wukv = p.w_ukv + (size_t)l * 128 * 512;
      const float* qn = p.qnorm + l * 256; const float* kn = p.kvnorm + l * 128;
      for (int r = gw; r < M; r += ngw) {
        const bf16_t* pr = PROJ + (size_t)r * IN_COLS;
        const float posf = (float)p.pos[r];
        float c4[4]; float ss = 0.f;
#pragma unroll
        for (int j = 0; j < 4; ++j) { c4[j] = bf2f(pr[C_CQ + lane + 64 * j]); ss += c4[j] * c4[j]; }
        float rr = rsqrtf(wave_sum(ss) * (1.f / 256.f) + EPS);
#pragma unroll
        for (int j = 0; j < 4; ++j) sc[lane + 64 * j] = c4[j] * rr * qn[lane + 64 * j];
        __builtin_amdgcn_s_waitcnt(0xc07f);
        float qa[6] = {0.f, 0.f, 0.f, 0.f, 0.f, 0.f};
        for (int k = 0; k < 256; ++k) { const float a = sc[k];
#pragma unroll
          for (int j = 0; j < 6; ++j) qa[j] += a * Wuq[(size_t)k * 384 + lane + 64 * j]; }
#pragma unroll
        for (int j = 0; j < 6; ++j) sq[lane + 64 * j] = qa[j];
        __builtin_amdgcn_s_waitcnt(0xc07f);
        for (int e = lane; e < 384; e += 64) {
          const int h = e / 96, d = e % 96; float v;
          if (d < 64) v = sq[h * 96 + d];
          else { const int i = (d - 64) & 15; const bool hi = (d - 64) >= 16; float s_, c_; sincos_big(posf * INV_FREQ[i], s_, c_);
            const float x1 = sq[h * 96 + 64 + i], x2 = sq[h * 96 + 80 + i]; v = hi ? (x1 * s_ + x2 * c_) : (x1 * c_ - x2 * s_); }
          QM[(size_t)r * 384 + e] = v;
        }
        __builtin_amdgcn_s_waitcnt(0xc07f);
        float d2[2]; ss = 0.f;
#pragma unroll
        for (int j = 0; j < 2; ++j) { d2[j] = bf2f(pr[C_CKV + lane + 64 * j]); ss += d2[j] * d2[j]; }
        rr = rsqrtf(wave_sum(ss) * (1.f / 128.f) + EPS);
#pragma unroll
        for (int j = 0; j < 2; ++j) sc[lane + 64 * j] = d2[j] * rr * kn[lane + 64 * j];
        __builtin_amdgcn_s_waitcnt(0xc07f);
        float ka[8] = {0.f, 0.f, 0.f, 0.f, 0.f, 0.f, 0.f, 0.f};
        for (int k = 0; k < 128; ++k) { const float a = sc[k];
#pragma unroll
          for (int j = 0; j < 8; ++j) ka[j] += a * Wukv[(size_t)k * 512 + lane + 64 * j]; }
#pragma unroll
        for (int j = 0; j < 8; ++j) { const int h = j >> 1; if ((j & 1) == 0) KM[(size_t)r * 384 + h * 96 + lane] = ka[j]; else VM[(size_t)r * 256 + h * 64 + lane] = ka[j]; }
        if (lane < 32) { const int i = lane & 15; const bool hi = lane >= 16; float s_, c_; sincos_big(posf * INV_FREQ[i], s_, c_);
          const float x1 = bf2f(pr[C_KR + i]), x2 = bf2f(pr[C_KR + 16 + i]); const float v = hi ? (x1 * s_ + x2 * c_) : (x1 * c_ - x2 * s_);
#pragma unroll
          for (int h = 0; h < 4; ++h) KM[(size_t)r * 384 + h * 96 + 64 + lane] = v; }
        __builtin_amdgcn_s_waitcnt(0xc07f);
      }
    }
    grid.sync();
    { PHASE_IDS
      int* ubox = (int*)(sm + 30000);
      const int rowi = tid >> 1, half = tid & 1;
      for (;;) {
        __syncthreads();
        if (tid == 0) *ubox = (int)atomicAdd(ctl + CW_UNIT + 64 * l, 1u);
        __syncthreads();
        const int u0 = *ubox;
        if (u0 >= 776) break;
        const int u = (u0 < 8) ? (256 + u0) : (u0 < 264 ? u0 - 8 : u0);
        if (u < 256) {
#ifndef NO_MLA
          const int qb = 31 - (u >> 3), bh = u & 7, b = bh >> 2, h = bh & 3;
          const int t = qb * 256 + rowi; const size_t r = (size_t)b * SEQ + t;
          float q[48], o[32];
#pragma unroll
          for (int d = 0; d < 48; ++d) q[d] = QM[r * 384 + h * 96 + half * 48 + d] * 0.10206207261596577f;
#pragma unroll
          for (int d = 0; d < 32; ++d) o[d] = 0.f;
          float mrun = -1e30f, lrun = 0.f;
          float* sK = sm; float* sV = sm + 16 * 96;
          const int nkt = (qb * 256 + 256) / 16;
          for (int kt = 0; kt < nkt; ++kt) {
            __syncthreads();
            for (int e = tid; e < 16 * 96; e += NT) { const int j = e / 96, d = e % 96; sK[e] = KM[((size_t)b * SEQ + kt * 16 + j) * 384 + h * 96 + d]; }
            for (int e = tid; e < 16 * 64; e += NT) { const int j = e / 64, d = e % 64; sV[e] = VM[((size_t)b * SEQ + kt * 16 + j) * 256 + h * 64 + d]; }
            __syncthreads();
#pragma unroll 1
            for (int j = 0; j < 16; ++j) { float a = 0.f;
#pragma unroll
              for (int d = 0; d < 48; ++d) a += q[d] * sK[j * 96 + half * 48 + d];
              a += __shfl_xor(a, 1);
              if (kt * 16 + j <= t) {
                const float mn = fmaxf(mrun, a), al = expf(mrun - mn), pj = expf(a - mn);
                lrun = lrun * al + pj; mrun = mn;
#pragma unroll
                for (int d = 0; d < 32; ++d) o[d] = o[d] * al + pj * sV[j * 64 + half * 32 + d];
              } }
          }
          const float inv = 1.f / lrun;
#pragma unroll
          for (int d = 0; d < 32; ++d) Y[r * DM + 0 + h * 64 + half * 32 + d] = o[d] * inv;
#endif
        } else if (u < 264) {
#ifndef NO_HGRN
          const int bh = u - 256, b = bh >> 2, h = bh & 3;
          float* sQ = sm; float* sF = sm + 4096; float* sI = sm + 8192; float* sG = sm + 12288;
          float S[64];
#pragma unroll
          for (int k = 0; k < 64; ++k) S[k] = 0.f;
          const float nw = p.hnorm[l * 256 + h * 64 + lane];
          for (int c = 0; c < SEQ / 64; ++c) {
            __syncthreads();
            for (int e = tid; e < 4096; e += NT) { const int s_ = e >> 6, k = e & 63; const bf16_t* pr = PROJ + ((size_t)b * SEQ + c * 64 + s_) * IN_COLS;
              float lb = 0.f; if (l == 1) { const float l0 = p.lbl[h * 64 + k], l1 = p.lbl[256 + h * 64 + k]; lb = 1.f / (1.f + expf(l0 - l1)); }
              sQ[e] = siluf_(bf2f(pr[C_HQ + h * 64 + k])); sF[e] = lb + (1.f - lb) * sigmoidf_(bf2f(pr[C_HF + h * 64 + k]));
              sI[e] = bf2f(pr[C_HI + h * 64 + k]); sG[e] = bf2f(pr[C_HG + h * 64 + k]); }
            __syncthreads();
            if (wave == 0) {
              for (int s_ = 0; s_ < 64; ++s_) {
                const float vi = sI[s_ * 64 + lane]; float ov = 0.f;
#pragma unroll
                for (int k = 0; k < 64; ++k) { const float f = sF[s_ * 64 + k]; S[k] = f * S[k] + (1.f - f) * vi; ov += sQ[s_ * 64 + k] * S[k]; }
                const float ms = wave_sum(ov * ov) * (1.f / 64.f);
                const float outv = ov * rsqrtf(ms + EPS) * nw * siluf_(sG[s_ * 64 + lane]);
                Y[((size_t)b * SEQ + c * 64 + s_) * DM + 512 + h * 64 + lane] = outv;
              }
            }
          }
#endif
        } else if (u < 520) {
#ifndef NO_SB
          const int v_ = u - 264, qb = v_ >> 3, bh = v_ & 7, b = bh >> 2, h = bh & 3;
          const int t = qb * 256 + rowi; const size_t r = (size_t)b * SEQ + t;
          float q[32], o[32];
#pragma unroll
          for (int d = 0; d < 32; ++d) { q[d] = bf2f(PROJ[r * IN_COLS + C_SBQ + h * 64 + half * 32 + d]) * 0.125f; o[d] = 0.f; }
          float run = 0.f;
          float* sK = sm; float* sV = sm + 1024;
          for (int kt = (qb * 256 + 255) / 16; kt >= 0; --kt) {
            __syncthreads();
            for (int e = tid; e < 1024; e += NT) { const int j = e >> 6, d = e & 63; const bf16_t* pr = PROJ + ((size_t)b * SEQ + kt * 16 + j) * IN_COLS;
              sK[e] = bf2f(pr[C_SBK + h * 64 + d]); sV[e] = bf2f(pr[C_SBV + h * 64 + d]); }
            __syncthreads();
#pragma unroll 1
            for (int j = 15; j >= 0; --j) { float z = 0.f;
#pragma unroll
              for (int d = 0; d < 32; ++d) z += q[d] * sK[j * 64 + half * 32 + d];
              z += __shfl_xor(z, 1);
              const bool valid = (kt * 16 + j) < t;
              const float lsz = logsigf_(z); const float a = valid ? expf(lsz + run) : 0.f;
#pragma unroll
              for (int d = 0; d < 32; ++d) o[d] += a * sV[j * 64 + half * 32 + d];
              run += valid ? (lsz - z) : 0.f; }
            const int done = ((run < -88.0f) || (kt == 0)) ? 1 : 0;
            if (__syncthreads_and(done)) break;
          }
#pragma unroll
          for (int d = 0; d < 32; ++d) Y[r * DM + 768 + h * 64 + half * 32 + d] = o[d];
#endif
        } else {
#ifndef NO_SWA
          const int v_ = u - 520, qb = v_ >> 3, bh = v_ & 7, b = bh >> 2, h = bh & 3, kvh = h >> 1;
          const int t = qb * 256 + rowi; const size_t r = (size_t)b * SEQ + t;
          const int pq = p.pos[r];
          float q[32], o[32];
#pragma unroll
          for (int d = 0; d < 32; ++d) { q[d] = bf2f(PROJ[r * IN_COLS + C_SWQ + h * 64 + half * 32 + d]) * 0.125f; o[d] = 0.f; }
          float mrun = p.sinks[l * 4 + h], lrun = 1.f;
          float* sK = sm; float* sV = sm + 1024; int* sP = (int*)(sm + 2048);
          int k0 = qb * 256 - 127; if (k0 < 0) k0 = 0;
          for (int kt = k0 / 16; kt <= (qb * 256 + 255) / 16; ++kt) {
            __syncthreads();
            for (int e = tid; e < 1024; e += NT) { const int j = e >> 6, d = e & 63; const bf16_t* pr = PROJ + ((size_t)b * SEQ + kt * 16 + j) * IN_COLS;
              sK[e] = bf2f(pr[C_SWK + kvh * 64 + d]); sV[e] = bf2f(pr[C_SWV + kvh * 64 + d]); }
            if (tid < 16) sP[tid] = p.pos[(size_t)b * SEQ + kt * 16 + tid];
            __syncthreads();
#pragma unroll 1
            for (int j = 0; j < 16; ++j) { float a = 0.f;
#pragma unroll
              for (int d = 0; d < 32; ++d) a += q[d] * sK[j * 64 + half * 32 + d];
              a += __shfl_xor(a, 1);
              const int key = kt * 16 + j; const bool valid = (key <= t) && (key >= t - 127);
              a += p.rel[rel_bucket(pq - sP[j]) * 4 + h];
              if (valid) {
                const float mn = fmaxf(mrun, a), al = expf(mrun - mn), pj = expf(a - mn);
                lrun = lrun * al + pj; mrun = mn;
#pragma unroll
                for (int d = 0; d < 32; ++d) o[d] = o[d] * al + pj * sV[j * 64 + half * 32 + d];
              } }
          }
          const float inv = 1.f / lrun;
#pragma unroll
          for (int d = 0; d < 32; ++d) Y[r * DM + 256 + h * 64 + half * 32 + d] = o[d] * inv;
#endif
        }
      }
    }
    grid.sync();
    { PHASE_IDS
      const float* Wb = p.w_branch + (size_t)l * 4 * 256 * DM;
      const int ntiles = (M / 128) * 8;
      for (int t = bid; t < ntiles; t += G) {
        const int tm = t / 8, tn = t % 8;
        float mg[4][8];
#pragma unroll
        for (int i = 0; i < 4; ++i)
#pragma unroll
          for (int j = 0; j < 8; ++j) mg[i][j] = 0.f;
        for (int n = 0; n < 4; ++n) {
          tile_mm<float, false>(acc, acc2, Y + n * 256, DM, nullptr, tm * 128, Wb + (size_t)n * 256 * DM, nullptr, DM, tn * 128, DM, 256, sm);
#pragma unroll
          for (int i = 0; i < 4; ++i)
#pragma unroll
            for (int j = 0; j < 8; ++j) { const int r = tm * 128 + ty * 4 + i, c = tn * 128 + tx * 8 + j;
              mg[i][j] += bf2f(PROJ[(size_t)r * IN_COLS + C_GATE + n * DM + c]) * acc[i][j]; }
        }
#pragma unroll
        for (int i = 0; i < 4; ++i)
#pragma unroll
          for (int j = 0; j < 8; ++j) MG[(size_t)(tm * 128 + ty * 4 + i) * DM + tn * 128 + tx * 8 + j] = mg[i][j];
      }
    }
    grid.sync();
    { PHASE_IDS
      const float* Wo = p.w_out + (size_t)l * DM * DM;
      for (int t = bid; t < (M / 128) * 8; t += G) {
        const int tm = t / 8, tn = t % 8;
        tile_mm<float, false>(acc, acc2, MG, DM, nullptr, tm * 128, Wo, nullptr, DM, tn * 128, DM, DM, sm);
#pragma unroll
        for (int i = 0; i < 4; ++i)
#pragma unroll
          for (int j = 0; j < 8; ++j) { const size_t o = (size_t)(tm * 128 + ty * 4 + i) * DM + tn * 128 + tx * 8 + j; T[o] = ALPHA * xin[o] + acc[i][j]; }
      }
    }
    grid.sync();
    { PHASE_IDS ln_rows(T, X, p.ln_g + (l * 3 + 0) * DM, p.ln_b + (l * 3 + 0) * DM, gw, ngw, lane); }
    grid.sync();
    { PHASE_IDS
      const float* Wq = p.xa_wq + (size_t)l * DM * 256;
      for (int t = bid; t < (M / 128) * 2; t += G) {
        const int tm = t / 2, tn = t % 2;
        tile_mm<float, false>(acc, acc2, X, DM, nullptr, tm * 128, Wq, nullptr, 256, tn * 128, 256, DM, sm);
#pragma unroll
        for (int i = 0; i < 4; ++i)
#pragma unroll
          for (int j = 0; j < 8; ++j) XQ[(size_t)(tm * 128 + ty * 4 + i) * 256 + tn * 128 + tx * 8 + j] = acc[i][j];
      }
    }
    grid.sync();
    { PHASE_IDS
      const int rowi = tid >> 1, half = tid & 1;
      for (int u = bid; u < 256; u += G) {
        const int qb = u >> 3, bh = u & 7, b = bh >> 2, h = bh & 3;
        const size_t r = (size_t)b * SEQ + qb * 256 + rowi;
        float q[32], o[32];
#pragma unroll
        for (int d = 0; d < 32; ++d) { q[d] = XQ[r * 256 + h * 64 + half * 32 + d] * 0.125f; o[d] = 0.f; }
        float mrun = -1e30f, lrun = 0.f;
        float* sK = sm; float* sV = sm + 1024;
        for (int kt = 0; kt < 16; ++kt) {
          __syncthreads();
          for (int e = tid; e < 1024; e += NT) { const int j = e >> 6, d = e & 63; const float* kr = KVMEM + (size_t)(b * 256 + kt * 16 + j) * 512;
            sK[e] = kr[h * 64 + d]; sV[e] = kr[256 + h * 64 + d]; }
          __syncthreads();
#pragma unroll 1
          for (int j = 0; j < 16; ++j) { float a = 0.f;
#pragma unroll
            for (int d = 0; d < 32; ++d) a += q[d] * sK[j * 64 + half * 32 + d];
            a += __shfl_xor(a, 1);
            const float mn = fmaxf(mrun, a), al = expf(mrun - mn), pj = expf(a - mn);
            lrun = lrun * al + pj; mrun = mn;
#pragma unroll
            for (int d = 0; d < 32; ++d) o[d] = o[d] * al + pj * sV[j * 64 + half * 32 + d]; }
        }
        const float inv = 1.f / lrun;
#pragma unroll
        for (int d = 0; d < 32; ++d) XO[r * 256 + h * 64 + half * 32 + d] = o[d] * inv;
        __syncthreads();
      }
    }
    grid.sync();
    { PHASE_IDS
      const float* Wo = p.xa_wo + (size_t)l * 256 * DM;
      for (int t = bid; t < (M / 128) * 8; t += G) {
        const int tm = t / 8, tn = t % 8;
        tile_mm<float, false>(acc, acc2, XO, 256, nullptr, tm * 128, Wo, nullptr, DM, tn * 128, DM, 256, sm);
#pragma unroll
        for (int i = 0; i < 4; ++i)
#pragma unroll
          for (int j = 0; j < 8; ++j) { const size_t o = (size_t)(tm * 128 + ty * 4 + i) * DM + tn * 128 + tx * 8 + j; T[o] = ALPHA * X[o] + acc[i][j]; }
      }
    }
    grid.sync();
    { PHASE_IDS ln_rows(T, X, p.ln_g + (l * 3 + 1) * DM, p.ln_b + (l * 3 + 1) * DM, gw, ngw, lane); }
    grid.sync();
    if (l == 0) {
      { PHASE_IDS
        const float* W13 = p.ffn_w13;
        for (int t = bid; t < (M / 128) * (F_DENSE / 128); t += G) {
          const int tm = t / (F_DENSE / 128), tn = t % (F_DENSE / 128);
          tile_mm<float, true>(acc, acc2, X, DM, nullptr, tm * 128, W13, W13 + F_DENSE, 2 * F_DENSE, tn * 128, F_DENSE, DM, sm);
#pragma unroll
          for (int i = 0; i < 4; ++i)
#pragma unroll
            for (int j = 0; j < 8; ++j) H2[(size_t)(tm * 128 + ty * 4 + i) * F_DENSE + tn * 128 + tx * 8 + j] = f2bf(siluf_(acc[i][j]) * acc2[i][j]);
        }
      }
      grid.sync();
      { PHASE_IDS
        for (int t = bid; t < (M / 128) * 8; t += G) {
          const int tm = t / 8, tn = t % 8;
          tile_mm<bf16_t, false>(acc, acc2, H2, F_DENSE, nullptr, tm * 128, p.ffn_w2, nullptr, DM, tn * 128, DM, F_DENSE, sm);
#pragma unroll
          for (int i = 0; i < 4; ++i)
#pragma unroll
            for (int j = 0; j < 8; ++j) { const size_t o = (size_t)(tm * 128 + ty * 4 + i) * DM + tn * 128 + tx * 8 + j; T[o] = ALPHA * X[o] + acc[i][j]; }
        }
      }
      grid.sync();
      { PHASE_IDS ln_rows(T, X, p.ln_g + (l * 3 + 2) * DM, p.ln_b + (l * 3 + 2) * DM, gw, ngw, lane); }
      grid.sync();
    } else {
      { PHASE_IDS
        for (int i = bid * NT + tid; i < CAP; i += G * NT) slot_tok[i] = -1;
        for (int r = gw; r < M; r += ngw) {
          float lg[8];
#pragma unroll
          for (int e = 0; e < 8; ++e) lg[e] = 0.f;
          for (int j = 0; j < 16; ++j) { const int k = lane + 64 * j; const float xv = X[(size_t)r * DM + k];
            const f32x4 w0 = *(const f32x4*)(p.router + (size_t)k * 8), w1 = *(const f32x4*)(p.router + (size_t)k * 8 + 4);
            lg[0] += xv * w0[0]; lg[1] += xv * w0[1]; lg[2] += xv * w0[2]; lg[3] += xv * w0[3]; lg[4] += xv * w1[0]; lg[5] += xv * w1[1]; lg[6] += xv * w1[2]; lg[7] += xv * w1[3]; }
#pragma unroll
          for (int e = 0; e < 8; ++e) lg[e] = wave_sum(lg[e]);
          int e0 = 0; float v0 = lg[0];
#pragma unroll
          for (int e = 1; e < 8; ++e) if (lg[e] > v0) { v0 = lg[e]; e0 = e; }
          int e1 = -1; float v1 = -3.0e38f;
#pragma unroll
          for (int e = 0; e < 8; ++e) if (e != e0 && lg[e] > v1) { v1 = lg[e]; e1 = e; }
          if (lane == 0) {
            const float w1_ = 1.f / (1.f + expf(v0 - v1)), w0_ = 1.f - w1_;
            const int p0 = (int)atomicAdd(ctl + CW_CNT + e0, 1u), p1 = (int)atomicAdd(ctl + CW_CNT + e1, 1u);
            tok_e[2 * r] = e0; tok_e[2 * r + 1] = e1; tok_p[2 * r] = p0; tok_p[2 * r + 1] = p1; tok_w[2 * r] = w0_; tok_w[2 * r + 1] = w1_;
          }
        }
      }
      grid.sync();
      int pstart[9];
      { PHASE_IDS
        int a = 0;
#pragma unroll
        for (int e = 0; e < 8; ++e) { pstart[e] = a; const int c = (int)__hip_atomic_load(ctl + CW_CNT + e, __ATOMIC_RELAXED, __HIP_MEMORY_SCOPE_AGENT); a += (c + 255) / 256 * 256; }
        pstart[8] = a;
        for (int i = bid * NT + tid; i < 2 * M; i += G * NT) { const int e = tok_e[i];
          int st = 0;
#pragma unroll
          for (int q = 0; q < 8; ++q) if (q == e) st = pstart[q];
          const int dest = st + tok_p[i]; tok_slot[i] = dest; slot_tok[dest] = i >> 1; }
      }
      grid.sync();
      const int nrt = pstart[8] / 128;
      { PHASE_IDS
        for (int t = bid; t < nrt * (F_EXP / 128); t += G) {
          const int tm = t / (F_EXP / 128), tn = t % (F_EXP / 128);
          int e = 0;
#pragma unroll
          for (int q = 1; q < 8; ++q) if (tm * 128 >= pstart[q]) e = q;
          const float* W13 = p.moe_w13 + (size_t)e * DM * 2 * F_EXP;
          tile_mm<float, true>(acc, acc2, X, DM, slot_tok, tm * 128, W13, W13 + F_EXP, 2 * F_EXP, tn * 128, F_EXP, DM, sm);
#pragma unroll
          for (int i = 0; i < 4; ++i)
#pragma unroll
            for (int j = 0; j < 8; ++j) H2[(size_t)(tm * 128 + ty * 4 + i) * F_EXP + tn * 128 + tx * 8 + j] = f2bf(siluf_(acc[i][j]) * acc2[i][j]);
        }
      }
      grid.sync();
      { PHASE_IDS
        for (int t = bid; t < nrt * 8; t += G) {
          const int tm = t / 8, tn = t % 8;
          int e = 0;
#pragma unroll
          for (int q = 1; q < 8; ++q) if (tm * 128 >= pstart[q]) e = q;
          const float* W2 = p.moe_w2 + (size_t)e * F_EXP * DM;
          tile_mm<bf16_t, false>(acc, acc2, H2, F_EXP, nullptr, tm * 128, W2, nullptr, DM, tn * 128, DM, F_EXP, sm);
#pragma unroll
          for (int i = 0; i < 4; ++i)
#pragma unroll
            for (int j = 0; j < 8; ++j) YS[(size_t)(tm * 128 + ty * 4 + i) * DM + tn * 128 + tx * 8 + j] = acc[i][j];
        }
      }
      grid.sync();
      { PHASE_IDS
        const float* g = p.ln_g + (l * 3 + 2) * DM; const float* bb_ = p.ln_b + (l * 3 + 2) * DM;
        for (int r = gw; r < M; r += ngw) {
          const int s0 = tok_slot[2 * r], s1 = tok_slot[2 * r + 1]; const float w0 = tok_w[2 * r], w1 = tok_w[2 * r + 1];
          f32x4 v[4]; float s = 0.f;
#pragma unroll
          for (int j = 0; j < 4; ++j) { const f32x4 xv = ((const f32x4*)(X + (size_t)r * DM))[lane + 64 * j];
            const f32x4 y0 = ((const f32x4*)(YS + (size_t)s0 * DM))[lane + 64 * j], y1 = ((const f32x4*)(YS + (size_t)s1 * DM))[lane + 64 * j];
            v[j] = xv * ALPHA + y0 * w0 + y1 * w1; s += (v[j][0] + v[j][1]) + (v[j][2] + v[j][3]); }
          const float mean = wave_sum(s) * (1.f / DM); float s2 = 0.f;
#pragma unroll
          for (int j = 0; j < 4; ++j) { v[j] = v[j] - mean; s2 += (v[j][0] * v[j][0] + v[j][1] * v[j][1]) + (v[j][2] * v[j][2] + v[j][3] * v[j][3]); }
          const float rstd = rsqrtf(wave_sum(s2) * (1.f / DM) + EPS);
          f32x4* o = (f32x4*)(p.out + (size_t)r * DM) + lane;
#pragma unroll
          for (int j = 0; j < 4; ++j) { const f32x4 gg = ((const f32x4*)g)[lane + 64 * j], bv = ((const f32x4*)bb_)[lane + 64 * j]; o[64 * j] = v[j] * rstd * gg + bv; }
        }
      }
    }
  }
}

constexpr int LDS_BYTES = 147456;
extern "C" void kernel_launch(void* const* d_in, const int* in_sizes, int n_in, void* d_out, int out_size, void* d_ws, size_t ws_size, hipStream_t stream) {
  static int grid = 0;
  if (grid == 0) {
    int dev = 0, cus = 0, per_cu = 0;
    hipGetDevice(&dev);
    hipDeviceGetAttribute(&cus, hipDeviceAttributeMultiprocessorCount, dev);
    hipFuncSetAttribute((const void*)mega, hipFuncAttributeMaxDynamicSharedMemorySize, LDS_BYTES);
    hipOccupancyMaxActiveBlocksPerMultiprocessor(&per_cu, (const void*)mega, NT, LDS_BYTES);
    if (per_cu < 1) { fprintf(stderr, "occupancy query says %d blocks/CU\n", per_cu); per_cu = 1; }
    if (per_cu > 1) per_cu = 1;
    grid = cus * per_cu;
    if (ws_size < WS_END) { fprintf(stderr, "workspace too small: %zu < %zu\n", ws_size, (size_t)WS_END); grid = -1; }
  }
  if (grid < 0) return;
  hipMemsetAsync((char*)d_ws + WS_CTL, 0, 1 * MiB, stream);
  Params p{};
  const float** f = (const float**)&p;
  for (int i = 0; i < 24; ++i) f[i] = (const float*)d_in[i];
  p.pos = (const int*)d_in[2];
  p.out = (float*)d_out; p.ws = (unsigned char*)d_ws;
  void* args[] = {&p};
  hipError_t e = hipLaunchCooperativeKernel((const void*)mega, dim3(grid), dim3(NT), args, LDS_BYTES, stream);
  if (e != hipSuccess) fprintf(stderr, "cooperative launch failed: %s (grid %d)\n", hipGetErrorString(e), grid);
}
```

```cpp
#include <hip/hip_runtime.h>
#include <hip/hip_cooperative_groups.h>
#include <cstdio>
#include <cstdint>
namespace cg = cooperative_groups;

namespace pg8 {
#define PG8_LAS __attribute__((address_space(3)))
typedef unsigned short bf16_t;
typedef short bf16x8 __attribute__((ext_vector_type(8)));
typedef float f32x4 __attribute__((ext_vector_type(4)));
typedef unsigned u32x4 __attribute__((ext_vector_type(4)));
constexpr int BM = 256, BK = 64, HALF = 128, HTB = HALF * BK * 2  , STAGE_BYTES = 8 * HTB, NXCD = 8, WGM = 8;

__host__ __device__ __forceinline__ int lds_byte(int r, int c) { const int st = (r >> 4) * 2 + (c >> 5), rr = r & 15, cc = c & 31, ob = rr * 64 + cc * 2; return st * 1024 + (ob ^ (((ob >> 9) & 1) << 5)); }
__host__ __device__ __forceinline__ void stage_rc(int b, int& R, int& C) { const int st = b / 1024, sb = b % 1024, swz = sb ^ (((sb >> 9) & 1) << 5); R = (st >> 1) * 16 + swz / 64; C = (st & 1) * 32 + (swz % 64) / 2; }
__host__ __device__ __forceinline__ int perm32(int rho) { const int n = rho >> 4, i = rho & 15; return 8 * (i >> 2) + 4 * n + (i & 3); }


struct Unit { int pm, pn; const char* a; const char* b; int aux; };
struct Gemm { int lda, ldb, K; };
__device__ __forceinline__ void glds16_s(const void* sbase, unsigned voff, unsigned lds_dst) { unsigned keep;
  asm volatile("s_mov_b32 %0, m0\n\ts_mov_b32 m0, %3\n\ts_nop 0\n\tglobal_load_lds_dwordx4 %2, %1\n\ts_mov_b32 m0, %0" : "=&s"(keep) : "s"(sbase), "v"(voff), "s"(lds_dst) : "memory"); }
__device__ __forceinline__ const char* uni_ptr(const char* q) { const unsigned long long v = (unsigned long long)(uintptr_t)q;
  const unsigned lo = __builtin_amdgcn_readfirstlane((unsigned)v), hi = __builtin_amdgcn_readfirstlane((unsigned)(v >> 32)); return (const char*)(uintptr_t)(((unsigned long long)hi << 32) | lo); }
__device__ __forceinline__ unsigned cvt_pk_bf16(float lo, float hi) { unsigned r; asm volatile("v_cvt_pk_bf16_f32 %0, %1, %2" : "=v"(r) : "v"(lo), "v"(hi)); return r; }
template <class Epi, class Sched, bool ALIGN_EPI = false, bool SP2 = false>
__device__ __forceinline__ void gemm_phase(PG8_LAS unsigned char* lds, const Gemm g, const Sched& S, const Epi& E) {
    int tid_l = (int)threadIdx.x; asm volatile("" : "+v"(tid_l));
    const int tid = tid_l, wid = __builtin_amdgcn_readfirstlane(tid >> 6), lane = tid & 63, wr = wid >> 2, wc = wid & 3, fr = lane & 15, fq = lane >> 4;
    const int K = g.K, nt = K / BK;
    unsigned voffA[2], voffB[2];
#pragma unroll
    for (int i = 0; i < 2; ++i) { int R, C; stage_rc(tid * 16 + i * 8192, R, C); const int Rb = Epi::PERM ? ((R & ~31) + perm32(R & 31)) : R;
        voffA[i] = (unsigned)(R * g.lda + C) * 2u; voffB[i] = (unsigned)(Rb * g.ldb + C) * 2u; }
    const size_t kstep = (size_t)(BK * 2);
    const size_t hstepA = (size_t)HALF * g.lda * 2, hstepB = (size_t)HALF * g.ldb * 2;
    const unsigned ldsb = (unsigned)(uintptr_t)lds;
    const unsigned ldsw = (unsigned)wid * 1024u;
    const int aoff = lds_byte(wr * 64 + fr, fq * 8), boff = lds_byte(wc * 32 + fr, fq * 8);
#define PG8_SA(b, h) (((b) * 2 + (h)) * HTB)
#define PG8_SB(b, h) ((4 + (b) * 2 + (h)) * HTB)
#define PG8_STAGE(bufoff, gbase, voff) do { _Pragma("unroll") for (int _i = 0; _i < 2; ++_i) \
        glds16_s((const void*)(gbase), (voff)[_i], (unsigned)__builtin_amdgcn_readfirstlane((int)(ldsb + (unsigned)(bufoff) + ldsw + (unsigned)(_i * 8192)))); } while (0)
#define PG8_LDA(dst, b, h) do { _Pragma("unroll") for (int m = 0; m < 4; ++m) _Pragma("unroll") for (int k = 0; k < 2; ++k) dst[m][k] = *(const PG8_LAS bf16x8*)(lds + PG8_SA(b, h) + aoff + m * 2048 + k * 1024); } while (0)
#define PG8_LDB(dst, b, h) do { _Pragma("unroll") for (int n = 0; n < 2; ++n) _Pragma("unroll") for (int k = 0; k < 2; ++k) dst[n][k] = *(const PG8_LAS bf16x8*)(lds + PG8_SB(b, h) + boff + n * 2048 + k * 1024); } while (0)
#define PG8_MMA(ai, bj, At, Bt) do { __builtin_amdgcn_s_setprio(1); _Pragma("unroll") for (int m = 0; m < 4; ++m) _Pragma("unroll") for (int n = 0; n < 2; ++n) _Pragma("unroll") for (int k = 0; k < 2; ++k) \
        acc[ai][bj][m][n] = __builtin_amdgcn_mfma_f32_16x16x32_bf16(Bt[n][k], At[m][k], acc[ai][bj][m][n], 0, 0, 0); __builtin_amdgcn_s_setprio(0); } while (0)
#define PG8_WAIT_V(n) asm volatile("s_waitcnt vmcnt(" #n ")" ::: "memory")
#define PG8_WAIT_L(n) asm volatile("s_waitcnt lgkmcnt(" #n ")" ::: "memory")
#define PG8_BAR __builtin_amdgcn_s_barrier()
#define PG8_SCHED __builtin_amdgcn_sched_barrier(0)
    Unit cur, nxt; int ui = 0;
    if (!S.next(0, cur)) return;
    f32x4 acc[2][2][4][2];
#pragma unroll
    for (int a = 0; a < 2; ++a)
#pragma unroll
        for (int b = 0; b < 2; ++b)
#pragma unroll
            for (int m = 0; m < 4; ++m)
#pragma unroll
                for (int n = 0; n < 2; ++n) acc[a][b][m][n] = (f32x4){0.f, 0.f, 0.f, 0.f};
    bf16x8 At[4][2], B0[2][2], B1[2][2];
    const char* cA = uni_ptr(cur.a); const char* cB = uni_ptr(cur.b);
    S.a_ready(cur);
    if constexpr (SP2) {
        PG8_STAGE(PG8_SB(0, 0), cB, voffB); PG8_STAGE(PG8_SB(0, 1), cB + hstepB, voffB); PG8_STAGE(PG8_SA(0, 0), cA, voffA); PG8_STAGE(PG8_SA(0, 1), cA + hstepA, voffA);
        if (wr == 1) PG8_BAR;
        PG8_WAIT_V(2); PG8_BAR;
        PG8_STAGE(PG8_SB(1, 0), cB + kstep, voffB); PG8_STAGE(PG8_SA(1, 0), cA + kstep, voffA); PG8_STAGE(PG8_SB(1, 1), cB + hstepB + kstep, voffB);
        PG8_WAIT_V(6); PG8_BAR;
    } else {
        PG8_STAGE(PG8_SB(0, 0), cB, voffB); PG8_STAGE(PG8_SA(0, 0), cA, voffA); PG8_STAGE(PG8_SB(0, 1), cB + hstepB, voffB); PG8_STAGE(PG8_SA(0, 1), cA + hstepA, voffA);
        if (wr == 1) PG8_BAR;
        PG8_WAIT_V(4); PG8_BAR;
        PG8_STAGE(PG8_SB(1, 0), cB + kstep, voffB); PG8_STAGE(PG8_SA(1, 0), cA + kstep, voffA); PG8_STAGE(PG8_SB(1, 1), cB + hstepB + kstep, voffB);
        PG8_WAIT_V(6); PG8_BAR;
    }
    for (;;) {
        const bool has_next = S.next(ui + 1, nxt);
        const char* nA = has_next ? uni_ptr(nxt.a) : cA; const char* nB = has_next ? uni_ptr(nxt.b) : cB;
        for (int t = 0; t < nt; t += 2) {
            const bool last = (t == nt - 2);
            const char* a1 = cA + (size_t)(t + 1) * kstep;
            const char* a2 = last ? nA : cA + (size_t)(t + 2) * kstep; const char* b2 = last ? nB : cB + (size_t)(t + 2) * kstep;
            const char* a3 = a2 + kstep; const char* b3 = b2 + kstep;
            if (last && has_next) S.a_ready(nxt);
            if constexpr (SP2) {
            PG8_LDB(B0, 0, 0); PG8_LDB(B1, 0, 1); PG8_SCHED; PG8_LDA(At, 0, 0); PG8_STAGE(PG8_SA(1, 1), a1 + hstepA, voffA);
            PG8_WAIT_V(8); PG8_WAIT_L(0); PG8_BAR; PG8_MMA(0, 0, At, B0); PG8_MMA(0, 1, At, B1); PG8_BAR; PG8_SCHED;
            PG8_LDA(At, 0, 1); PG8_STAGE(PG8_SB(0, 0), b2, voffB); PG8_STAGE(PG8_SB(0, 1), b2 + hstepB, voffB); PG8_STAGE(PG8_SA(0, 0), a2, voffA);
            PG8_WAIT_V(8); PG8_WAIT_L(0); PG8_BAR; PG8_MMA(1, 0, At, B0); PG8_MMA(1, 1, At, B1); PG8_BAR; PG8_SCHED;
            PG8_LDB(B0, 1, 0); PG8_LDB(B1, 1, 1); PG8_SCHED; PG8_LDA(At, 1, 0); PG8_STAGE(PG8_SA(0, 1), a2 + hstepA, voffA);
            PG8_WAIT_V(8); PG8_WAIT_L(0); PG8_BAR; PG8_MMA(0, 0, At, B0); PG8_MMA(0, 1, At, B1); PG8_BAR; PG8_SCHED;
            PG8_LDA(At, 1, 1); PG8_STAGE(PG8_SB(1, 0), b3, voffB); PG8_STAGE(PG8_SB(1, 1), b3 + hstepB, voffB); PG8_STAGE(PG8_SA(1, 0), a3, voffA);
            PG8_WAIT_V(8); PG8_WAIT_L(0); PG8_BAR; PG8_MMA(1, 0, At, B0); PG8_MMA(1, 1, At, B1); PG8_BAR; PG8_SCHED;
            } else {
            PG8_LDB(B0, 0, 0); PG8_SCHED; PG8_LDA(At, 0, 0); PG8_STAGE(PG8_SA(1, 1), a1 + hstepA, voffA);
            PG8_WAIT_L(8); PG8_BAR; PG8_WAIT_L(0); PG8_MMA(0, 0, At, B0); PG8_BAR; PG8_SCHED;
            PG8_LDB(B1, 0, 1); PG8_STAGE(PG8_SB(0, 0), b2, voffB);
            PG8_BAR; PG8_WAIT_L(0); PG8_MMA(0, 1, At, B1); PG8_BAR;
            PG8_LDA(At, 0, 1); PG8_STAGE(PG8_SA(0, 0), a2, voffA);
            PG8_BAR; PG8_WAIT_L(0); PG8_MMA(1, 0, At, B0); PG8_BAR; PG8_SCHED;
            PG8_STAGE(PG8_SB(0, 1), b2 + hstepB, voffB);
            PG8_WAIT_V(6); PG8_BAR; PG8_MMA(1, 1, At, B1); PG8_BAR;
            PG8_LDB(B0, 1, 0); PG8_SCHED; PG8_LDA(At, 1, 0); PG8_STAGE(PG8_SA(0, 1), a2 + hstepA, voffA);
            PG8_WAIT_L(8); PG8_BAR; PG8_WAIT_L(0); PG8_MMA(0, 0, At, B0); PG8_BAR; PG8_SCHED;
            PG8_LDB(B1, 1, 1); PG8_STAGE(PG8_SB(1, 0), b3, voffB);
            PG8_BAR; PG8_WAIT_L(0); PG8_MMA(0, 1, At, B1); PG8_BAR;
            PG8_LDA(At, 1, 1); PG8_STAGE(PG8_SA(1, 0), a3, voffA);
            PG8_BAR; PG8_WAIT_L(0); PG8_MMA(1, 0, At, B0); PG8_BAR; PG8_SCHED;
            PG8_STAGE(PG8_SB(1, 1), b3 + hstepB, voffB);
            PG8_WAIT_V(6); PG8_BAR; PG8_MMA(1, 1, At, B1); PG8_BAR;
            }
        }
        if constexpr (ALIGN_EPI) { if (wr == 0) PG8_BAR; }
        if constexpr (!Epi::AFTER_DRAIN) { E(acc, cur, wr, wc, fr, fq); S.done(cur); }
        if (!has_next) break;
#pragma unroll
        for (int a = 0; a < 2; ++a)
#pragma unroll
            for (int b = 0; b < 2; ++b)
#pragma unroll
                for (int m = 0; m < 4; ++m)
#pragma unroll
                    for (int n = 0; n < 2; ++n) acc[a][b][m][n] = (f32x4){0.f, 0.f, 0.f, 0.f};
        cur = nxt; cA = nA; cB = nB; ++ui;
        if constexpr (ALIGN_EPI) { if (wr == 1) PG8_BAR; }
    }
    PG8_WAIT_V(0);
    if constexpr (!ALIGN_EPI) { if (wr == 0) PG8_BAR; }
    PG8_BAR;
    if constexpr (Epi::AFTER_DRAIN) { E.fused(acc, cur, wr, wc, fr, fq, lds, wid, lane); S.done(cur); }
#undef PG8_SA
#undef PG8_SB
#undef PG8_STAGE
#undef PG8_LDA
#undef PG8_LDB
#undef PG8_MMA
#undef PG8_WAIT_V
#undef PG8_WAIT_L
#undef PG8_BAR
#undef PG8_SCHED
}
}

typedef unsigned short bf16_t;
typedef float f32x4 __attribute__((ext_vector_type(4)));
typedef unsigned u32x4 __attribute__((ext_vector_type(4)));
typedef unsigned u32x2 __attribute__((ext_vector_type(2)));
#define LAS __attribute__((address_space(3)))

constexpr int DM = 1024, BATCH = 2, SEQ = 8192, M = BATCH * SEQ, DEPTH = 2, MEMLEN = 256;
constexpr int IN_COLS = 6816, IN_PAD = 6912;
constexpr int C_CQ = 0, C_CKV = 256, C_KR = 384, C_SWQ = 416, C_SWK = 672, C_SWV = 800, C_HQ = 928, C_HF = 1184, C_HI = 1440, C_HG = 1696,
              C_SBQ = 1952, C_SBK = 2208, C_SBV = 2464, C_GATE = 2720;
constexpr int F_DENSE = 2816, F_EXP = 3584, NEXP = 8;
constexpr int CAP = 2 * M + NEXP * 256;
constexpr float EPS = 1e-5f;
constexpr float ALPHA = 1.4142135623730951f;
constexpr int NT = 512;

constexpr size_t MiB = 1u << 20;
constexpr size_t WS_CTL = 0;
constexpr size_t WS_X = 1 * MiB;
constexpr size_t WS_T = WS_X + 64 * MiB;
constexpr size_t WS_XB = WS_T + 64 * MiB;
constexpr size_t WS_RA = WS_XB + 32 * MiB;
constexpr size_t WS_Y = WS_RA;
constexpr size_t WS_MB = WS_Y + 32 * MiB;
constexpr size_t WS_QM = WS_MB + 32 * MiB;
constexpr size_t WS_KM = WS_QM + 12 * MiB;
constexpr size_t WS_VM = WS_KM + 12 * MiB;
constexpr size_t WS_CQN = WS_VM + 8 * MiB;
constexpr size_t WS_CKVN = WS_CQN + 8 * MiB;
constexpr size_t WS_XQ = WS_CKVN + 8 * MiB;
constexpr size_t WS_XO = WS_XQ + 8 * MiB;
constexpr size_t WS_ROPE = WS_XO + 8 * MiB;
constexpr size_t WS_YS = WS_RA;
constexpr size_t WS_RA_END = WS_RA + 136 * MiB;
static_assert(WS_ROPE + 2 * MiB <= WS_RA_END, "region A");
constexpr size_t WS_KVMEM = WS_RA_END;
constexpr size_t WS_ROUTE = WS_KVMEM + 1 * MiB;
constexpr size_t WS_XG = WS_ROUTE + 4 * MiB;
constexpr size_t WS_BIG = WS_XG + 68 * MiB;
constexpr size_t WS_W = WS_BIG + 238 * MiB;
constexpr size_t W_IN = WS_W;
constexpr size_t W_UQ = W_IN + (size_t)2 * IN_PAD * 1024 * 2;
constexpr size_t W_UKV = W_UQ + (size_t)2 * 512 * 256 * 2;
constexpr size_t W_BR = W_UKV + (size_t)2 * 512 * 256 * 2;
constexpr size_t W_OUT = W_BR + (size_t)2 * 4 * 1024 * 256 * 2;
constexpr size_t W_XQ = W_OUT + (size_t)2 * 1024 * 1024 * 2;
constexpr size_t W_XO = W_XQ + (size_t)2 * 256 * 1024 * 2;
constexpr size_t W_F13 = W_XO + (size_t)2 * 1024 * 256 * 2;
constexpr size_t W_F2 = W_F13 + (size_t)5632 * 1024 * 2;
constexpr size_t W_M13 = W_F2 + (size_t)1024 * 2816 * 2;
constexpr size_t W_M2 = W_M13 + (size_t)8 * 7168 * 1024 * 2;
constexpr size_t WS_END = W_M2 + (size_t)8 * 1024 * 3584 * 2;
static_assert(WS_END <= (size_t)896 * MiB, "workspace");

constexpr int CW_CNT = 0;
constexpr int CW_UNIT = 64;
constexpr int CW_BAR = 4096;

struct Params {
  const float* x; const float* mem; const int* pos; const float* rel; const float* lbl; const float* w_in;
  const float* qnorm; const float* w_uq; const float* kvnorm; const float* w_ukv; const float* sinks; const float* hnorm;
  const float* w_branch; const float* w_out; const float* ln_g; const float* ln_b; const float* xa_wq; const float* xa_wkv; const float* xa_wo;
  const float* ffn_w13; const float* ffn_w2; const float* router; const float* moe_w13; const float* moe_w2;
  float* out; unsigned char* ws;
};

__device__ __forceinline__ float bf2f(bf16_t v) { return __uint_as_float((unsigned)v << 16); }
__device__ __forceinline__ bf16_t f2bf(float f) { unsigned u = __float_as_uint(f); return (bf16_t)((u + 0x7fffu + ((u >> 16) & 1u)) >> 16); }
__device__ __forceinline__ unsigned pk2(float lo, float hi) { return (unsigned)f2bf(lo) | ((unsigned)f2bf(hi) << 16); }
__device__ __forceinline__ float ldf(const float* p, size_t i) { return p[i]; }
__device__ __forceinline__ float ldf(const bf16_t* p, size_t i) { return bf2f(p[i]); }
__device__ __forceinline__ float sigmoidf_(float x) { return 1.0f / (1.0f + expf(-x)); }
__device__ __forceinline__ float siluf_(float x) { return x / (1.0f + expf(-x)); }
__device__ __forceinline__ float fast_sigmoid(float x) { return __builtin_amdgcn_rcpf(1.0f + __builtin_amdgcn_exp2f(-1.4426950408889634f * x)); }
__device__ __forceinline__ float logsigf_(float z) { return fminf(z, 0.0f) - log1pf(expf(-fabsf(z))); }
__device__ __forceinline__ float wave_sum(float v) {
#pragma unroll
  for (int o = 1; o < 64; o <<= 1) v += __shfl_xor(v, o);
  return v;
}
__device__ __forceinline__ int rel_bucket(int d) {
  int n = d > 0 ? d : 0;
  if (n < 16) return n;
  float nf = (float)n;
  int large = 16 + (int)(logf(nf / 16.0f) / 2.0794415416798357f * 16.0f);
  large = large < 0 ? 0 : (large > 31 ? 31 : large);
  return large;
}
__device__ const float INV_FREQ[16] = {1.0f, 0.5623413251903491f, 0.31622776601683794f, 0.1778279410038923f, 0.1f, 0.05623413251903491f, 0.031622776601683794f,
  0.01778279410038923f, 0.01f, 0.005623413251903491f, 0.0031622776601683794f, 0.001778279410038923f, 0.001f, 0.0005623413251903491f,
  0.00031622776601683794f, 0.0001778279410038923f};
__device__ __forceinline__ void sincos_big(float ang, float& s, float& c) {
  double rev = (double)ang * 0.15915494309189535;
  rev = rev - rint(rev);
  float fr = (float)rev;
  s = __builtin_amdgcn_sinf(fr); c = __builtin_amdgcn_cosf(fr);
}
__device__ __forceinline__ void* ptab_get(LAS const unsigned long long* tab, int i) {
  const unsigned long long v = tab[i]; const unsigned lo = __builtin_amdgcn_readfirstlane((unsigned)v), hi = __builtin_amdgcn_readfirstlane((unsigned)(v >> 32));
  return (void*)(uintptr_t)(((unsigned long long)hi << 32) | lo); }
__device__ __forceinline__ int launder(int v) { asm volatile("" : "+v"(v)); return v; }
__device__ __forceinline__ int launder_s(int v) { asm volatile("" : "+s"(v)); return v; }
__device__ __forceinline__ LAS unsigned char* launder_lds(LAS unsigned char* q) { unsigned v = (unsigned)(uintptr_t)q; asm volatile("" : "+s"(v)); return (LAS unsigned char*)(uintptr_t)v; }
#define PHASE_IDS const int bid = launder_s(bid0), G = launder_s(G0), ngw = G * 8; LAS unsigned char* lds3 = launder_lds(lds30); \
  LAS const unsigned long long* PTAB = (LAS const unsigned long long*)(lds3 + 131072 + 1024); unsigned char* ws = (unsigned char*)ptab_get(PTAB, 25); \
  const int tid = launder((int)threadIdx.x), lane = tid & 63, wave = tid >> 6, gw = bid * 8 + wave, ty = tid >> 4, tx = tid & 15; (void)lane; (void)wave; (void)gw; (void)ty; (void)tx; (void)ngw; (void)ws;

template <typename TA, bool DUAL>
__device__ __forceinline__ void tile_mm(float (&acc)[4][8], float (&acc2)[4][8], const TA* A, int lda, const int* ridx, int row0,
                                        const float* B, const float* B2, int ldb, int col0, int N, int K, float* sm) {
  float* sA = sm; float* sB = sm + 16 * 132; float* sB2 = sm + 32 * 132;
  const int tid = launder((int)threadIdx.x), ty = tid >> 4, tx = tid & 15;
  const int ar = tid >> 2, ak = (tid & 3) * 4;
  const int bk = tid >> 5, bc = (tid & 31) * 4;
  long arow = ridx ? (long)ridx[row0 + ar] : (long)(row0 + ar);
#pragma unroll
  for (int i = 0; i < 4; ++i)
#pragma unroll
    for (int j = 0; j < 8; ++j) { acc[i][j] = 0.f; acc2[i][j] = 0.f; }
  const bool bval = (col0 + bc) < N;
  for (int k0 = 0; k0 < K; k0 += 16) {
    float a0 = 0.f, a1 = 0.f, a2 = 0.f, a3 = 0.f;
    if (arow >= 0) { const size_t o = (size_t)arow * lda + k0 + ak; a0 = ldf(A, o); a1 = ldf(A, o + 1); a2 = ldf(A, o + 2); a3 = ldf(A, o + 3); }
    f32x4 b = {0.f, 0.f, 0.f, 0.f}, b2 = {0.f, 0.f, 0.f, 0.f};
    if (bval) { b = *(const f32x4*)(B + (size_t)(k0 + bk) * ldb + col0 + bc); if (DUAL) b2 = *(const f32x4*)(B2 + (size_t)(k0 + bk) * ldb + col0 + bc); }
    __syncthreads();
    sA[(ak + 0) * 132 + ar] = a0; sA[(ak + 1) * 132 + ar] = a1; sA[(ak + 2) * 132 + ar] = a2; sA[(ak + 3) * 132 + ar] = a3;
    *(f32x4*)&sB[bk * 132 + bc] = b;
    if (DUAL) *(f32x4*)&sB2[bk * 132 + bc] = b2;
    __syncthreads();
#pragma unroll 4
    for (int kk = 0; kk < 16; ++kk) {
      const f32x4 a = *(const f32x4*)&sA[kk * 132 + ty * 4];
      const f32x4 p = *(const f32x4*)&sB[kk * 132 + tx * 8], q = *(const f32x4*)&sB[kk * 132 + tx * 8 + 4];
#pragma unroll
      for (int i = 0; i < 4; ++i) {
        acc[i][0] += a[i] * p[0]; acc[i][1] += a[i] * p[1]; acc[i][2] += a[i] * p[2]; acc[i][3] += a[i] * p[3];
        acc[i][4] += a[i] * q[0]; acc[i][5] += a[i] * q[1]; acc[i][6] += a[i] * q[2]; acc[i][7] += a[i] * q[3];
      }
      if (DUAL) {
        const f32x4 p2 = *(const f32x4*)&sB2[kk * 132 + tx * 8], q2 = *(const f32x4*)&sB2[kk * 132 + tx * 8 + 4];
#pragma unroll
        for (int i = 0; i < 4; ++i) {
          acc2[i][0] += a[i] * p2[0]; acc2[i][1] += a[i] * p2[1]; acc2[i][2] += a[i] * p2[2]; acc2[i][3] += a[i] * p2[3];
          acc2[i][4] += a[i] * q2[0]; acc2[i][5] += a[i] * q2[1]; acc2[i][6] += a[i] * q2[2]; acc2[i][7] += a[i] * q2[3];
        }
      }
    }
  }
  __syncthreads();
}


#define XB_TMO      128
#define XB_XCNT(j)  (256  + 64 * (j))
#define XB_XSUB(j)  (1280 + 64 * (j))
#define XB_XGEN(j)  (2304 + 64 * (j))
#define XB_TOP      3328
#define XB_TOPGEN   3392
#define XCD_BAR_WORDS 3456
#define XB_SPIN_CAP (1u << 18)

__device__ __forceinline__ unsigned xb_ld(unsigned* p)              { return __hip_atomic_load(p, __ATOMIC_RELAXED, __HIP_MEMORY_SCOPE_AGENT); }
__device__ __forceinline__ unsigned xb_add(unsigned* p, unsigned v) { return __hip_atomic_fetch_add(p, v, __ATOMIC_RELAXED, __HIP_MEMORY_SCOPE_AGENT); }
__device__ __forceinline__ unsigned xb_xcc_id() { return (unsigned)__builtin_amdgcn_s_getreg((3 << 11) | 20) & 0xFu; }
#define XB_SPIN(cond, bar) do { unsigned _sp = 0; while (cond) { __builtin_amdgcn_s_sleep(1); \
    if ((++_sp & 255u) == 0u) { if (xb_ld(&(bar)[XB_TMO])) break; if (_sp > XB_SPIN_CAP) { atomicAdd(&(bar)[XB_TMO], 1u); break; } } } } while (0)

struct XcdBarrier {
    unsigned* bar; unsigned x;
    volatile LAS unsigned* st;
};

__device__ __forceinline__ XcdBarrier xcd_barrier_post(unsigned* bar, volatile LAS unsigned* st) {
    XcdBarrier b; b.bar = bar; b.x = xb_xcc_id(); b.st = st;
    if (threadIdx.x == 0) (void)xb_add(&bar[XB_XCNT(b.x)], 1u);
    return b;
}
__device__ __forceinline__ void xcd_barrier_complete(unsigned* bar, unsigned x, unsigned& nloc, unsigned& nx) {
    const unsigned G = gridDim.x * gridDim.y * gridDim.z;
    unsigned sum, cnt, mine, sp = 0u;
    for (;;) {
        sum = 0u; cnt = 0u; mine = 0u;
#pragma unroll
        for (unsigned j = 0; j < 16; ++j) { const unsigned c = xb_ld(&bar[XB_XCNT(j)]); sum += c; cnt += (c > 0u) ? 1u : 0u; mine = (j == x) ? c : mine; }
        if (sum == G) break;
        __builtin_amdgcn_s_sleep(1);
        if ((++sp & 255u) == 0u) { if (xb_ld(&bar[XB_TMO])) break; if (sp > XB_SPIN_CAP) { atomicAdd(&bar[XB_TMO], 1u); break; } }
    }
    nloc = mine > 0u ? mine : 1u; nx = cnt > 0u ? cnt : 1u;
}

__device__ __forceinline__ void xcd_barrier(const XcdBarrier& b) {
    asm volatile("s_waitcnt vmcnt(0)" ::: "memory");
    __syncthreads();
    if (threadIdx.x == 0) {
        unsigned* bar = b.bar;
        __builtin_amdgcn_s_waitcnt(0);
        unsigned nloc = b.st[0], nx = b.st[1];
        if (nloc == 0u) { xcd_barrier_complete(bar, b.x, nloc, nx); b.st[0] = nloc; b.st[1] = nx; }
        const unsigned old = xb_add(&bar[XB_XSUB(b.x)], 1u);
        const unsigned gen = old / nloc;
        if (old + 1u == (gen + 1u) * nloc) {
            __builtin_amdgcn_fence(__ATOMIC_RELEASE, "agent");
            asm volatile("s_waitcnt vmcnt(0)" ::: "memory");
            const unsigned og = xb_add(&bar[XB_TOP], 1u);
            const unsigned tg = og / nx;
            if (og + 1u == (tg + 1u) * nx) xb_add(&bar[XB_TOPGEN], 1u);
            else XB_SPIN(xb_ld(&bar[XB_TOPGEN]) == tg, bar);
            __builtin_amdgcn_fence(__ATOMIC_ACQUIRE, "agent");
            xb_add(&bar[XB_XGEN(b.x)], 1u);
            asm volatile("s_waitcnt vmcnt(0)" ::: "memory");
        } else {
            XB_SPIN(xb_ld(&bar[XB_XGEN(b.x)]) == gen, bar);
            __builtin_amdgcn_fence(__ATOMIC_ACQUIRE, "agent");
            asm volatile("s_waitcnt vmcnt(0)" ::: "memory");
        }
    }
    __syncthreads();
}

__device__ __forceinline__ bool tile_of(long L, int nM, int nN, int& pm, int& pn) {
  const int nwg = nM * nN; if (L >= nwg) return false;
  int wgid = (int)L; { const int q = nwg / 8, r = nwg % 8, xcd = wgid % 8, off = wgid / 8; wgid = (xcd < r ? xcd * (q + 1) : r * (q + 1) + (xcd - r) * q) + off; }
  const int nig = 8 * nN, gid = wgid / nig, fm = gid * 8, gsz = (nM - fm) < 8 ? (nM - fm) : 8;
  pm = fm + ((wgid % nig) % gsz); pn = (wgid % nig) / gsz; return true;
}
struct SchedGrid {
  const char* A; const char* B; size_t at, bt; int nM, nN, G, c;
  __device__ __forceinline__ bool next(int i, pg8::Unit& u) const { int pm, pn; if (!tile_of((long)i * G + c, nM, nN, pm, pn)) return false;
    u.pm = pm; u.pn = pn; u.a = A + (size_t)pm * at; u.b = B + (size_t)pn * bt; u.aux = 0; return true; }
  __device__ __forceinline__ void a_ready(const pg8::Unit&) const {}
  __device__ __forceinline__ void done(const pg8::Unit&) const {}
};
struct SchedUp {
  const char* A0; const char* B0; const char* A1; const char* B1; int G, c;
  __device__ __forceinline__ bool next(int i, pg8::Unit& u) const { const int L = i * G + c; if (L >= 256) return false;
    const int grp = L >> 7, t = L & 127; u.pm = t >> 1; u.pn = t & 1; u.aux = grp;
    u.a = (grp ? A1 : A0) + (size_t)u.pm * (256 * 256 * 2); u.b = (grp ? B1 : B0) + (size_t)u.pn * (256 * 256 * 2); return true; }
  __device__ __forceinline__ void a_ready(const pg8::Unit&) const {}
  __device__ __forceinline__ void done(const pg8::Unit&) const {}
};
struct SchedBranch {
  const char* Y; const char* W; int G, c;
  __device__ __forceinline__ bool next(int i, pg8::Unit& u) const { int pm, pn; if (!tile_of((long)(i >> 2) * G + c, 64, 4, pm, pn)) return false;
    const int n = i & 3; u.pm = pm; u.pn = pn; u.aux = n;
    u.a = Y + (size_t)pm * (256 * 1024 * 2) + n * 512; u.b = W + (size_t)n * (1024 * 256 * 2) + (size_t)pn * (256 * 256 * 2); return true; }
  __device__ __forceinline__ void a_ready(const pg8::Unit&) const {}
  __device__ __forceinline__ void done(const pg8::Unit&) const {}
};
struct SchedMoE {
  const char* A; const char* B; size_t at, bt, be; int nM, nN, G, c; int ps1, ps2, ps3, ps4, ps5, ps6, ps7;
  __device__ __forceinline__ bool next(int i, pg8::Unit& u) const { int pm, pn; if (!tile_of((long)i * G + c, nM, nN, pm, pn)) return false;
    const int r0 = pm * 256; const int e = (r0 >= ps1) + (r0 >= ps2) + (r0 >= ps3) + (r0 >= ps4) + (r0 >= ps5) + (r0 >= ps6) + (r0 >= ps7);
    u.pm = pm; u.pn = pn; u.aux = e; u.a = A + (size_t)pm * at; u.b = B + (size_t)e * be + (size_t)pn * bt; return true; }
  __device__ __forceinline__ void a_ready(const pg8::Unit&) const {}
  __device__ __forceinline__ void done(const pg8::Unit&) const {}
};

typedef const pg8::f32x4 (&AccRef)[2][2][4][2];
struct EpiProj { static constexpr bool PERM = true, AFTER_DRAIN = false; bf16_t* O;
  __device__ __forceinline__ void operator()(AccRef acc, const pg8::Unit& u, int wr, int wc, int fr, int fq) const {
    const int row0 = u.pm * 256 + wr * 64 + fr;
#pragma unroll
    for (int ai = 0; ai < 2; ++ai)
#pragma unroll
      for (int m = 0; m < 4; ++m) { bf16_t* rowp = O + (size_t)(row0 + ai * 128 + m * 16) * IN_COLS;
#pragma unroll
        for (int bj = 0; bj < 2; ++bj) { const int c0 = u.pn * 256 + bj * 128 + wc * 32 + 8 * fq;
          if (c0 < IN_COLS) { pg8::f32x4 v0 = acc[ai][bj][m][0], v1 = acc[ai][bj][m][1];
            if (c0 >= C_GATE) {
#pragma unroll
              for (int j = 0; j < 4; ++j) { v0[j] = fast_sigmoid(v0[j]); v1[j] = fast_sigmoid(v1[j]); } }
            u32x4 w; w.x = pg8::cvt_pk_bf16(v0[0], v0[1]); w.y = pg8::cvt_pk_bf16(v0[2], v0[3]); w.z = pg8::cvt_pk_bf16(v1[0], v1[1]); w.w = pg8::cvt_pk_bf16(v1[2], v1[3]);
            *(u32x4*)(rowp + c0) = w; } } }
  }
};
struct EpiUp { static constexpr bool PERM = false, AFTER_DRAIN = false; bf16_t* QM; bf16_t* KM; bf16_t* VM; const float* rope;
  __device__ __forceinline__ void operator()(AccRef acc, const pg8::Unit& u, int wr, int wc, int fr, int fq) const {
    const int row0 = u.pm * 256 + wr * 64 + fr;
    if (u.aux == 0) {
      const float sc = 0.10206207261596577f;
#pragma unroll
      for (int bj = 0; bj < 2; ++bj) { const int g32 = (u.pn * 256 + bj * 128 + wc * 32) >> 5;
        if (g32 < 12) { const int h = g32 / 3, part = g32 - 3 * h;
#pragma unroll
          for (int ai = 0; ai < 2; ++ai)
#pragma unroll
            for (int m = 0; m < 4; ++m) { const int r = row0 + ai * 128 + m * 16; bf16_t* dst = QM + (size_t)r * 384 + h * 96 + part * 32 + 4 * fq;
              pg8::f32x4 v0 = acc[ai][bj][m][0], v1 = acc[ai][bj][m][1];
              if (part == 2) { const f32x4 cs = *(const f32x4*)(rope + (size_t)r * 32 + 4 * fq), sn = *(const f32x4*)(rope + (size_t)r * 32 + 16 + 4 * fq);
                const pg8::f32x4 a = v0, b = v1;
#pragma unroll
                for (int j = 0; j < 4; ++j) { v0[j] = a[j] * cs[j] - b[j] * sn[j]; v1[j] = a[j] * sn[j] + b[j] * cs[j]; } }
              u32x2 w0, w1; w0.x = pg8::cvt_pk_bf16(v0[0] * sc, v0[1] * sc); w0.y = pg8::cvt_pk_bf16(v0[2] * sc, v0[3] * sc);
              w1.x = pg8::cvt_pk_bf16(v1[0] * sc, v1[1] * sc); w1.y = pg8::cvt_pk_bf16(v1[2] * sc, v1[3] * sc);
              *(u32x2*)dst = w0; *(u32x2*)(dst + 16) = w1; } } }
    } else {
#pragma unroll
      for (int bj = 0; bj < 2; ++bj) { const int h = u.pn * 2 + bj;
#pragma unroll
        for (int ai = 0; ai < 2; ++ai)
#pragma unroll
          for (int m = 0; m < 4; ++m) { const int r = row0 + ai * 128 + m * 16;
#pragma unroll
            for (int n = 0; n < 2; ++n) { const int w = wc * 32 + 16 * n + 4 * fq; const pg8::f32x4 v = acc[ai][bj][m][n];
              u32x2 o; o.x = pg8::cvt_pk_bf16(v[0], v[1]); o.y = pg8::cvt_pk_bf16(v[2], v[3]);
              if (w < 64) *(u32x2*)(KM + (size_t)r * 384 + h * 96 + w) = o; else *(u32x2*)(VM + (size_t)r * 256 + h * 64 + (w - 64)) = o; } } }
    }
  }
};
struct EpiMerge { static constexpr bool PERM = true, AFTER_DRAIN = false; const bf16_t* PROJ; float* TMP; bf16_t* MB;
  __device__ __forceinline__ void operator()(AccRef acc, const pg8::Unit& u, int wr, int wc, int fr, int fq) const {
    const int row0 = u.pm * 256 + wr * 64 + fr, n = u.aux;
#pragma unroll
    for (int ai = 0; ai < 2; ++ai)
#pragma unroll
      for (int m = 0; m < 4; ++m) { const int r = row0 + ai * 128 + m * 16;
#pragma unroll
        for (int bj = 0; bj < 2; ++bj) { const int c0 = u.pn * 256 + bj * 128 + wc * 32 + 8 * fq;
          const u32x4 gw_ = *(const u32x4*)(PROJ + (size_t)r * IN_COLS + C_GATE + n * DM + c0);
          pg8::f32x4 v0 = acc[ai][bj][m][0], v1 = acc[ai][bj][m][1];
          v0[0] *= __uint_as_float(gw_.x << 16); v0[1] *= __uint_as_float(gw_.x & 0xffff0000u); v0[2] *= __uint_as_float(gw_.y << 16); v0[3] *= __uint_as_float(gw_.y & 0xffff0000u);
          v1[0] *= __uint_as_float(gw_.z << 16); v1[1] *= __uint_as_float(gw_.z & 0xffff0000u); v1[2] *= __uint_as_float(gw_.w << 16); v1[3] *= __uint_as_float(gw_.w & 0xffff0000u);
          float* tp = TMP + (size_t)r * DM + c0;
          if (n > 0) { v0 += *(const pg8::f32x4*)tp; v1 += *(const pg8::f32x4*)(tp + 4); }
          if (n < 3) { *(pg8::f32x4*)tp = v0; *(pg8::f32x4*)(tp + 4) = v1; }
          else { u32x4 w; w.x = pg8::cvt_pk_bf16(v0[0], v0[1]); w.y = pg8::cvt_pk_bf16(v0[2], v0[3]); w.z = pg8::cvt_pk_bf16(v1[0], v1[1]); w.w = pg8::cvt_pk_bf16(v1[2], v1[3]);
            *(u32x4*)(MB + (size_t)r * DM + c0) = w; } } }
  }
};
struct EpiRes { static constexpr bool PERM = false, AFTER_DRAIN = false; const float* res; float* T;
  __device__ __forceinline__ void operator()(AccRef acc, const pg8::Unit& u, int wr, int wc, int fr, int fq) const {
    const int row0 = u.pm * 256 + wr * 64 + fr, col0 = u.pn * 256 + wc * 32 + 4 * fq;
#pragma unroll
    for (int ai = 0; ai < 2; ++ai)
#pragma unroll
      for (int m = 0; m < 4; ++m) { const size_t off = (size_t)(row0 + ai * 128 + m * 16) * DM + col0;
#pragma unroll
        for (int bj = 0; bj < 2; ++bj)
#pragma unroll
          for (int n = 0; n < 2; ++n) { const pg8::f32x4 rv = *(const pg8::f32x4*)(res + off + bj * 128 + n * 16);
            *(pg8::f32x4*)(T + off + bj * 128 + n * 16) = rv * ALPHA + acc[ai][bj][m][n]; } }
  }
};
struct EpiBf { static constexpr bool PERM = true, AFTER_DRAIN = false; bf16_t* O; int ldc; float sc;
  __device__ __forceinline__ void operator()(AccRef acc, const pg8::Unit& u, int wr, int wc, int fr, int fq) const {
    const int row0 = u.pm * 256 + wr * 64 + fr;
#pragma unroll
    for (int ai = 0; ai < 2; ++ai)
#pragma unroll
      for (int m = 0; m < 4; ++m) { bf16_t* rowp = O + (size_t)(row0 + ai * 128 + m * 16) * ldc + u.pn * 256 + wc * 32 + 8 * fq;
#pragma unroll
        for (int bj = 0; bj < 2; ++bj) { const pg8::f32x4 v0 = acc[ai][bj][m][0] * sc, v1 = acc[ai][bj][m][1] * sc;
          u32x4 w; w.x = pg8::cvt_pk_bf16(v0[0], v0[1]); w.y = pg8::cvt_pk_bf16(v0[2], v0[3]); w.z = pg8::cvt_pk_bf16(v1[0], v1[1]); w.w = pg8::cvt_pk_bf16(v1[2], v1[3]);
          *(u32x4*)(rowp + bj * 128) = w; } }
  }
};
struct EpiSwiGLU { static constexpr bool PERM = true, AFTER_DRAIN = false; bf16_t* H; int ldh;
  __device__ __forceinline__ void operator()(AccRef acc, const pg8::Unit& u, int wr, int wc, int fr, int fq) const {
    const int row0 = u.pm * 256 + wr * 64 + fr;
#pragma unroll
    for (int ai = 0; ai < 2; ++ai)
#pragma unroll
      for (int m = 0; m < 4; ++m) { bf16_t* dst = H + (size_t)(row0 + ai * 128 + m * 16) * ldh + u.pn * 128 + wc * 32 + 8 * fq;
        float h[8];
#pragma unroll
        for (int n = 0; n < 2; ++n)
#pragma unroll
          for (int j = 0; j < 4; ++j) { const float a = acc[ai][0][m][n][j], g = acc[ai][1][m][n][j]; h[n * 4 + j] = a * fast_sigmoid(a) * g; }
        u32x4 w; w.x = pg8::cvt_pk_bf16(h[0], h[1]); w.y = pg8::cvt_pk_bf16(h[2], h[3]); w.z = pg8::cvt_pk_bf16(h[4], h[5]); w.w = pg8::cvt_pk_bf16(h[6], h[7]);
        *(u32x4*)dst = w; }
  }
};
struct EpiF32 { static constexpr bool PERM = false, AFTER_DRAIN = false; float* O;
  __device__ __forceinline__ void operator()(AccRef acc, const pg8::Unit& u, int wr, int wc, int fr, int fq) const {
    const int row0 = u.pm * 256 + wr * 64 + fr, col0 = u.pn * 256 + wc * 32 + 4 * fq;
#pragma unroll
    for (int ai = 0; ai < 2; ++ai)
#pragma unroll
      for (int m = 0; m < 4; ++m) { const size_t off = (size_t)(row0 + ai * 128 + m * 16) * DM + col0;
#pragma unroll
        for (int bj = 0; bj < 2; ++bj)
#pragma unroll
          for (int n = 0; n < 2; ++n) *(pg8::f32x4*)(O + off + bj * 128 + n * 16) = acc[ai][bj][m][n]; }
  }
};

__device__ __forceinline__ void tr_item(const float* W, int ldw, int k0, int n0, bf16_t* dst, int dst_ld, int drow0, LAS float* scr, int lane) {
#pragma unroll 8
  for (int i = 0; i < 32; ++i) { const int kk = 2 * i + (lane >> 5); scr[kk * 33 + (lane & 31)] = W[(size_t)(k0 + kk) * ldw + n0 + (lane & 31)]; }
  asm volatile("s_waitcnt lgkmcnt(0)" ::: "memory");
  const int c = lane & 7;
#pragma unroll
  for (int j = 0; j < 4; ++j) { const int n = (lane >> 3) + 8 * j; const LAS float* s = scr + (8 * c) * 33 + n;
    u32x4 o; o.x = pk2(s[0 * 33], s[1 * 33]); o.y = pk2(s[2 * 33], s[3 * 33]); o.z = pk2(s[4 * 33], s[5 * 33]); o.w = pk2(s[6 * 33], s[7 * 33]);
    *(u32x4*)(dst + (size_t)(drow0 + n) * dst_ld + k0 + 8 * c) = o; }
  asm volatile("s_waitcnt lgkmcnt(0)" ::: "memory");
}
__device__ __forceinline__ int pair_row(int c, int F) { const int g = c >= F ? 1 : 0, cc = c - g * F; return (cc >> 7) * 256 + g * 128 + (cc & 127); }

__device__ __forceinline__ void ln_rows(const float* T, float* dst, bf16_t* dstb, const float* g, const float* b, int gw, int ngw, int lane) {
  for (int r = gw; r < M; r += ngw) {
    const f32x4* tr = (const f32x4*)(T + (size_t)r * DM) + lane;
    f32x4 v[4]; float s = 0.f;
#pragma unroll
    for (int j = 0; j < 4; ++j) { v[j] = tr[64 * j]; s += (v[j][0] + v[j][1]) + (v[j][2] + v[j][3]); }
    const float mean = wave_sum(s) * (1.f / DM); float s2 = 0.f;
#pragma unroll
    for (int j = 0; j < 4; ++j) { v[j] = v[j] - mean; s2 += (v[j][0] * v[j][0] + v[j][1] * v[j][1]) + (v[j][2] * v[j][2] + v[j][3] * v[j][3]); }
    const float rstd = rsqrtf(wave_sum(s2) * (1.f / DM) + EPS);
    f32x4* o = (f32x4*)(dst + (size_t)r * DM) + lane; u32x2* ob = (u32x2*)(dstb + (size_t)r * DM) + lane;
#pragma unroll
    for (int j = 0; j < 4; ++j) { const f32x4 gg = ((const f32x4*)g)[lane + 64 * j], bb = ((const f32x4*)b)[lane + 64 * j]; const f32x4 y = v[j] * rstd * gg + bb; o[64 * j] = y;
      u32x2 w; w.x = pk2(y[0], y[1]); w.y = pk2(y[2], y[3]); ob[64 * j] = w; }
  }
}


__device__ __forceinline__ unsigned char* launder_p(unsigned char* q) { asm volatile("" : "+s"(q)); return q; }
#define ctl ((unsigned*)(ws + WS_CTL))
#define X ((float*)(ws + WS_X))
#define T ((float*)(ws + WS_T))
#define XB ((bf16_t*)(ws + WS_XB))
#define Y ((bf16_t*)(ws + WS_Y))
#define MB ((bf16_t*)(ws + WS_MB))
#define QM ((bf16_t*)(ws + WS_QM))
#define KM ((bf16_t*)(ws + WS_KM))
#define VM ((bf16_t*)(ws + WS_VM))
#define CQN ((bf16_t*)(ws + WS_CQN))
#define CKVN ((bf16_t*)(ws + WS_CKVN))
#define XQ ((bf16_t*)(ws + WS_XQ))
#define XO ((bf16_t*)(ws + WS_XO))
#define ROPE ((float*)(ws + WS_ROPE))
#define KVMEM ((float*)(ws + WS_KVMEM))
#define PROJ ((bf16_t*)(ws + WS_BIG))
#define H2 ((bf16_t*)(ws + WS_BIG))
#define YS ((float*)(ws + WS_YS))
#define XG ((bf16_t*)(ws + WS_XG))
#define tok_e ((int*)(ws + WS_ROUTE))
#define tok_p (tok_e + 2 * M)
#define tok_w ((float*)(tok_p + 2 * M))
#define tok_slot ((int*)(tok_w + 2 * M))
#define GEMM_PHASE(EpiT, SchedT, g, S, E) pg8::gemm_phase<EpiT, SchedT, true, true>(lds3, g, S, E)
__global__ void __launch_bounds__(NT) mega(Params p) {
  extern __shared__ __attribute__((aligned(16))) unsigned char lds_raw[];
  float* sm = (float*)lds_raw;
  LAS unsigned char* lds30 = (LAS unsigned char*)lds_raw;
  const int G0 = gridDim.x, bid0 = blockIdx.x;
  { LAS unsigned long long* PTAB = (LAS unsigned long long*)(lds30 + 131072 + 1024);
  if (threadIdx.x == 0) {
    PTAB[0] = (unsigned long long)(uintptr_t)p.x;
    PTAB[1] = (unsigned long long)(uintptr_t)p.mem;
    PTAB[2] = (unsigned long long)(uintptr_t)p.pos;
    PTAB[3] = (unsigned long long)(uintptr_t)p.rel;
    PTAB[4] = (unsigned long long)(uintptr_t)p.lbl;
    PTAB[5] = (unsigned long long)(uintptr_t)p.w_in;
    PTAB[6] = (unsigned long long)(uintptr_t)p.qnorm;
    PTAB[7] = (unsigned long long)(uintptr_t)p.w_uq;
    PTAB[8] = (unsigned long long)(uintptr_t)p.kvnorm;
    PTAB[9] = (unsigned long long)(uintptr_t)p.w_ukv;
    PTAB[10] = (unsigned long long)(uintptr_t)p.sinks;
    PTAB[11] = (unsigned long long)(uintptr_t)p.hnorm;
    PTAB[12] = (unsigned long long)(uintptr_t)p.w_branch;
    PTAB[13] = (unsigned long long)(uintptr_t)p.w_out;
    PTAB[14] = (unsigned long long)(uintptr_t)p.ln_g;
    PTAB[15] = (unsigned long long)(uintptr_t)p.ln_b;
    PTAB[16] = (unsigned long long)(uintptr_t)p.xa_wq;
    PTAB[17] = (unsigned long long)(uintptr_t)p.xa_wkv;
    PTAB[18] = (unsigned long long)(uintptr_t)p.xa_wo;
    PTAB[19] = (unsigned long long)(uintptr_t)p.ffn_w13;
    PTAB[20] = (unsigned long long)(uintptr_t)p.ffn_w2;
    PTAB[21] = (unsigned long long)(uintptr_t)p.router;
    PTAB[22] = (unsigned long long)(uintptr_t)p.moe_w13;
    PTAB[23] = (unsigned long long)(uintptr_t)p.moe_w2;
    PTAB[24] = (unsigned long long)(uintptr_t)p.out;
    PTAB[25] = (unsigned long long)(uintptr_t)p.ws;
  } }
  volatile LAS unsigned* MISC = (volatile LAS unsigned*)(lds30 + 131072 + 320);
  if (threadIdx.x < 32) MISC[threadIdx.x] = 0u;
  __syncthreads();
  const XcdBarrier xbar = xcd_barrier_post((unsigned*)(p.ws + WS_CTL) + CW_BAR, MISC + 8);
#define GRID_SYNC() xcd_barrier(xbar)
  { PHASE_IDS
    LAS float* scr = (LAS float*)(lds3 + wave * 16384);
    constexpr int I_IN = 16 * 213, I_UQ = 4 * 12, I_UKV = 2 * 16, I_BR = 4 * 32, I_OUT = 16 * 32, I_XQ = 16 * 8, I_XO = 4 * 32, I_F13 = 16 * 176, I_F2 = 44 * 32, I_M13 = 16 * 224, I_M2 = 56 * 32;
    constexpr int N_ITEMS = 2 * I_IN + 2 * I_UQ + 2 * I_UKV + 8 * I_BR + 2 * I_OUT + 2 * I_XQ + 2 * I_XO + I_F13 + I_F2 + 8 * I_M13 + 8 * I_M2;
    for (int it = gw; it < N_ITEMS; it += ngw) {
      int r = it;
      if (r < 2 * I_IN) { const int l = r / I_IN, q = r % I_IN, kb = q / 213, nb = q % 213;
        tr_item(((const float*)ptab_get(PTAB, 5)) + (size_t)l * DM * IN_COLS, IN_COLS, kb * 64, nb * 32, (bf16_t*)(ws + W_IN) + (size_t)l * IN_PAD * 1024, 1024, nb * 32, scr, lane); continue; } r -= 2 * I_IN;
      if (r < 2 * I_UQ) { const int l = r / I_UQ, q = r % I_UQ, kb = q / 12, nb = q % 12;
        tr_item(((const float*)ptab_get(PTAB, 7)) + (size_t)l * 256 * 384, 384, kb * 64, nb * 32, (bf16_t*)(ws + W_UQ) + (size_t)l * 512 * 256, 256, nb * 32, scr, lane); continue; } r -= 2 * I_UQ;
      if (r < 2 * I_UKV) { const int l = r / I_UKV, q = r % I_UKV, kb = q / 16, nb = q % 16;
        tr_item(((const float*)ptab_get(PTAB, 9)) + (size_t)l * 128 * 512, 512, kb * 64, nb * 32, (bf16_t*)(ws + W_UKV) + (size_t)l * 512 * 256, 256, nb * 32, scr, lane); continue; } r -= 2 * I_UKV;
      if (r < 8 * I_BR) { const int ln = r / I_BR, q = r % I_BR, kb = q / 32, nb = q % 32;
        tr_item(((const float*)ptab_get(PTAB, 12)) + (size_t)ln * 256 * 1024, 1024, kb * 64, nb * 32, (bf16_t*)(ws + W_BR) + (size_t)ln * 1024 * 256, 256, nb * 32, scr, lane); continue; } r -= 8 * I_BR;
      if (r < 2 * I_OUT) { const int l = r / I_OUT, q = r % I_OUT, kb = q / 32, nb = q % 32;
        tr_item(((const float*)ptab_get(PTAB, 13)) + (size_t)l * 1024 * 1024, 1024, kb * 64, nb * 32, (bf16_t*)(ws + W_OUT) + (size_t)l * 1024 * 1024, 1024, nb * 32, scr, lane); continue; } r -= 2 * I_OUT;
      if (r < 2 * I_XQ) { const int l = r / I_XQ, q = r % I_XQ, kb = q / 8, nb = q % 8;
        tr_item(((const float*)ptab_get(PTAB, 16)) + (size_t)l * 1024 * 256, 256, kb * 64, nb * 32, (bf16_t*)(ws + W_XQ) + (size_t)l * 256 * 1024, 1024, nb * 32, scr, lane); continue; } r -= 2 * I_XQ;
      if (r < 2 * I_XO) { const int l = r / I_XO, q = r % I_XO, kb = q / 32, nb = q % 32;
        tr_item(((const float*)ptab_get(PTAB, 18)) + (size_t)l * 256 * 1024, 1024, kb * 64, nb * 32, (bf16_t*)(ws + W_XO) + (size_t)l * 1024 * 256, 256, nb * 32, scr, lane); continue; } r -= 2 * I_XO;
      if (r < I_F13) { const int kb = r / 176, nb = r % 176;
        tr_item(((const float*)ptab_get(PTAB, 19)), 2 * F_DENSE, kb * 64, nb * 32, (bf16_t*)(ws + W_F13), 1024, pair_row(nb * 32, F_DENSE), scr, lane); continue; } r -= I_F13;
      if (r < I_F2) { const int kb = r / 32, nb = r % 32;
        tr_item(((const float*)ptab_get(PTAB, 20)), 1024, kb * 64, nb * 32, (bf16_t*)(ws + W_F2), F_DENSE, nb * 32, scr, lane); continue; } r -= I_F2;
      if (r < 8 * I_M13) { const int e = r / I_M13, q = r % I_M13, kb = q / 224, nb = q % 224;
        tr_item(((const float*)ptab_get(PTAB, 22)) + (size_t)e * 1024 * 2 * F_EXP, 2 * F_EXP, kb * 64, nb * 32, (bf16_t*)(ws + W_M13) + (size_t)e * 2 * F_EXP * 1024, 1024, pair_row(nb * 32, F_EXP), scr, lane); continue; } r -= 8 * I_M13;
      { const int e = r / I_M2, q = r % I_M2, kb = q / 32, nb = q % 32;
        tr_item(((const float*)ptab_get(PTAB, 23)) + (size_t)e * F_EXP * 1024, 1024, kb * 64, nb * 32, (bf16_t*)(ws + W_M2) + (size_t)e * 1024 * F_EXP, F_EXP, nb * 32, scr, lane); }
    }
    const int gt = bid * NT + tid, ngt = G * NT;
    for (int i = gt; i < 2 * 96 * 1024 / 8; i += ngt) { const int l = i / (96 * 128), q = i % (96 * 128); ((u32x4*)((bf16_t*)(ws + W_IN) + ((size_t)l * IN_PAD + IN_COLS) * 1024))[q] = (u32x4){0u, 0u, 0u, 0u}; }
    for (int i = gt; i < 2 * 128 * 256 / 8; i += ngt) { const int l = i / (128 * 32), q = i % (128 * 32); ((u32x4*)((bf16_t*)(ws + W_UQ) + ((size_t)l * 512 + 384) * 256))[q] = (u32x4){0u, 0u, 0u, 0u}; }
    for (int i = gt; i < 2 * 512 * 16; i += ngt) { const int row = i / 16, q = i % 16; ((u32x4*)((bf16_t*)(ws + W_UKV) + (size_t)row * 256 + 128))[q] = (u32x4){0u, 0u, 0u, 0u}; }
    for (int i = gt; i < M * DM / 4; i += ngt) { const f32x4 v = ((const f32x4*)((const float*)ptab_get(PTAB, 0)))[i]; u32x2 w; w.x = pk2(v[0], v[1]); w.y = pk2(v[2], v[3]); ((u32x2*)XB)[i] = w; }
  }
  cg::this_grid().sync();

  for (int l = 0; l < DEPTH; ++l) {
    { PHASE_IDS
      if (bid >= G - 16) {
        float acc[4][8], acc2[4][8];
        const float* Wkv = ((const float*)ptab_get(PTAB, 17)) + (size_t)l * DM * 512;
        const int t = bid - (G - 16), tm = t / 4, tn = t % 4;
        tile_mm<float, false>(acc, acc2, ((const float*)ptab_get(PTAB, 1)), DM, nullptr, tm * 128, Wkv, nullptr, 512, tn * 128, 512, DM, sm);
#pragma unroll
        for (int i = 0; i < 4; ++i)
#pragma unroll
          for (int j = 0; j < 8; ++j) KVMEM[(size_t)(tm * 128 + ty * 4 + i) * 512 + tn * 128 + tx * 8 + j] = acc[i][j];
        __syncthreads();
      }
      pg8::Gemm g{1024, 1024, 1024};
      SchedGrid S{(const char*)XB, (const char*)(ws + W_IN) + (size_t)l * IN_PAD * 1024 * 2, (size_t)256 * 1024 * 2, (size_t)256 * 1024 * 2, 64, 27, G, bid};
      EpiProj E{PROJ};
      GEMM_PHASE(EpiProj, SchedGrid, g, S, E);
    }
    GRID_SYNC();
    { PHASE_IDS
      const float* qn = ((const float*)ptab_get(PTAB, 6)) + l * 256; const float* kn = ((const float*)ptab_get(PTAB, 8)) + l * 128;
      for (int r = gw; r < M; r += ngw) {
        const bf16_t* pr = PROJ + (size_t)r * IN_COLS;
        const float posf = (float)((const int*)ptab_get(PTAB, 2))[r];
        float c4[4]; float ss = 0.f;
#pragma unroll
        for (int j = 0; j < 4; ++j) { c4[j] = bf2f(pr[C_CQ + lane + 64 * j]); ss += c4[j] * c4[j]; }
        float rr = rsqrtf(wave_sum(ss) * (1.f / 256.f) + EPS);
#pragma unroll
        for (int j = 0; j < 4; ++j) CQN[(size_t)r * 256 + lane + 64 * j] = f2bf(c4[j] * rr * qn[lane + 64 * j]);
        float d2[2]; ss = 0.f;
#pragma unroll
        for (int j = 0; j < 2; ++j) { d2[j] = bf2f(pr[C_CKV + lane + 64 * j]); ss += d2[j] * d2[j]; }
        rr = rsqrtf(wave_sum(ss) * (1.f / 128.f) + EPS);
#pragma unroll
        for (int j = 0; j < 2; ++j) { CKVN[(size_t)r * 256 + lane + 64 * j] = f2bf(d2[j] * rr * kn[lane + 64 * j]); CKVN[(size_t)r * 256 + 128 + lane + 64 * j] = 0; }
        if (lane < 32) { const int i = lane & 15; const bool hi = lane >= 16; float s_, c_; sincos_big(posf * INV_FREQ[i], s_, c_);
          ROPE[(size_t)r * 32 + lane] = hi ? s_ : c_;
          const float x1 = bf2f(pr[C_KR + i]), x2 = bf2f(pr[C_KR + 16 + i]); const bf16_t v = f2bf(hi ? (x1 * s_ + x2 * c_) : (x1 * c_ - x2 * s_));
#pragma unroll
          for (int h = 0; h < 4; ++h) KM[(size_t)r * 384 + h * 96 + 64 + lane] = v; }
      }
    }
    GRID_SYNC();
    { PHASE_IDS
      pg8::Gemm g{256, 256, 256};
      SchedUp S{(const char*)CQN, (const char*)(ws + W_UQ) + (size_t)l * 512 * 256 * 2, (const char*)CKVN, (const char*)(ws + W_UKV) + (size_t)l * 512 * 256 * 2, G, bid};
      EpiUp E{QM, KM, VM, ROPE};
      GEMM_PHASE(EpiUp, SchedUp, g, S, E);
    }
    GRID_SYNC();
    { PHASE_IDS
      int* ubox = (int*)(sm + 30000);
      const int rowi = tid >> 1, half = tid & 1;
      for (;;) {
        __syncthreads();
        if (tid == 0) *ubox = (int)atomicAdd(ctl + CW_UNIT + 64 * l, 1u);
        __syncthreads();
        const int u0 = *ubox;
        if (u0 >= 776) break;
        const int u = (u0 < 8) ? (256 + u0) : (u0 < 264 ? u0 - 8 : u0);
        if (u < 256) {
          const int qb = 31 - (u >> 3), bh = u & 7, b = bh >> 2, h = bh & 3;
          const int t = qb * 256 + rowi; const size_t r = (size_t)b * SEQ + t;
          float q[48], o[32];
#pragma unroll
          for (int d = 0; d < 48; ++d) q[d] = bf2f(QM[r * 384 + h * 96 + half * 48 + d]);
#pragma unroll
          for (int d = 0; d < 32; ++d) o[d] = 0.f;
          float mrun = -1e30f, lrun = 0.f;
          float* sK = sm; float* sV = sm + 16 * 96;
          const int nkt = (qb * 256 + 256) / 16;
          for (int kt = 0; kt < nkt; ++kt) {
            __syncthreads();
            for (int e = tid; e < 16 * 96; e += NT) { const int j = e / 96, d = e % 96; sK[e] = bf2f(KM[((size_t)b * SEQ + kt * 16 + j) * 384 + h * 96 + d]); }
            for (int e = tid; e < 16 * 64; e += NT) { const int j = e / 64, d = e % 64; sV[e] = bf2f(VM[((size_t)b * SEQ + kt * 16 + j) * 256 + h * 64 + d]); }
            __syncthreads();
#pragma unroll 1
            for (int j = 0; j < 16; ++j) { float a = 0.f;
#pragma unroll
              for (int d = 0; d < 48; ++d) a += q[d] * sK[j * 96 + half * 48 + d];
              a += __shfl_xor(a, 1);
              if (kt * 16 + j <= t) {
                const float mn = fmaxf(mrun, a), al = expf(mrun - mn), pj = expf(a - mn);
                lrun = lrun * al + pj; mrun = mn;
#pragma unroll
                for (int d = 0; d < 32; ++d) o[d] = o[d] * al + pj * sV[j * 64 + half * 32 + d];
              } }
          }
          const float inv = 1.f / lrun;
#pragma unroll
          for (int d = 0; d < 32; ++d) Y[r * DM + 0 + h * 64 + half * 32 + d] = f2bf(o[d] * inv);
        } else if (u < 264) {
          const int bh = u - 256, b = bh >> 2, h = bh & 3;
          float* sQ = sm; float* sF = sm + 4096; float* sI = sm + 8192; float* sG = sm + 12288;
          float S[64];
#pragma unroll
          for (int k = 0; k < 64; ++k) S[k] = 0.f;
          const float nw = ((const float*)ptab_get(PTAB, 11))[l * 256 + h * 64 + lane];
          for (int c = 0; c < SEQ / 64; ++c) {
            __syncthreads();
            for (int e = tid; e < 4096; e += NT) { const int s_ = e >> 6, k = e & 63; const bf16_t* pr = PROJ + ((size_t)b * SEQ + c * 64 + s_) * IN_COLS;
              float lb = 0.f; if (l == 1) { const float l0 = ((const float*)ptab_get(PTAB, 4))[h * 64 + k], l1 = ((const float*)ptab_get(PTAB, 4))[256 + h * 64 + k]; lb = 1.f / (1.f + expf(l0 - l1)); }
              sQ[e] = siluf_(bf2f(pr[C_HQ + h * 64 + k])); sF[e] = lb + (1.f - lb) * sigmoidf_(bf2f(pr[C_HF + h * 64 + k]));
              sI[e] = bf2f(pr[C_HI + h * 64 + k]); sG[e] = bf2f(pr[C_HG + h * 64 + k]); }
            __syncthreads();
            if (wave == 0) {
              for (int s_ = 0; s_ < 64; ++s_) {
                const float vi = sI[s_ * 64 + lane]; float ov = 0.f;
#pragma unroll
                for (int k = 0; k < 64; ++k) { const float f = sF[s_ * 64 + k]; S[k] = f * S[k] + (1.f - f) * vi; ov += sQ[s_ * 64 + k] * S[k]; }
                const float ms = wave_sum(ov * ov) * (1.f / 64.f);
                const float outv = ov * rsqrtf(ms + EPS) * nw * siluf_(sG[s_ * 64 + lane]);
                Y[((size_t)b * SEQ + c * 64 + s_) * DM + 512 + h * 64 + lane] = f2bf(outv);
              }
            }
          }
        } else if (u < 520) {
          const int v_ = u - 264, qb = v_ >> 3, bh = v_ & 7, b = bh >> 2, h = bh & 3;
          const int t = qb * 256 + rowi; const size_t r = (size_t)b * SEQ + t;
          float q[32], o[32];
#pragma unroll
          for (int d = 0; d < 32; ++d) { q[d] = bf2f(PROJ[r * IN_COLS + C_SBQ + h * 64 + half * 32 + d]) * 0.125f; o[d] = 0.f; }
          float run = 0.f;
          float* sK = sm; float* sV = sm + 1024;
          for (int kt = (qb * 256 + 255) / 16; kt >= 0; --kt) {
            __syncthreads();
            for (int e = tid; e < 1024; e += NT) { const int j = e >> 6, d = e & 63; const bf16_t* pr = PROJ + ((size_t)b * SEQ + kt * 16 + j) * IN_COLS;
              sK[e] = bf2f(pr[C_SBK + h * 64 + d]); sV[e] = bf2f(pr[C_SBV + h * 64 + d]); }
            __syncthreads();
#pragma unroll 1
            for (int j = 15; j >= 0; --j) { float z = 0.f;
#pragma unroll
              for (int d = 0; d < 32; ++d) z += q[d] * sK[j * 64 + half * 32 + d];
              z += __shfl_xor(z, 1);
              const bool valid = (kt * 16 + j) < t;
              const float lsz = logsigf_(z); const float a = valid ? expf(lsz + run) : 0.f;
#pragma unroll
              for (int d = 0; d < 32; ++d) o[d] += a * sV[j * 64 + half * 32 + d];
              run += valid ? (lsz - z) : 0.f; }
            const int done = ((run < -88.0f) || (kt == 0)) ? 1 : 0;
            if (__syncthreads_and(done)) break;
          }
#pragma unroll
          for (int d = 0; d < 32; ++d) Y[r * DM + 768 + h * 64 + half * 32 + d] = f2bf(o[d]);
        } else {
          const int v_ = u - 520, qb = v_ >> 3, bh = v_ & 7, b = bh >> 2, h = bh & 3, kvh = h >> 1;
          const int t = qb * 256 + rowi; const size_t r = (size_t)b * SEQ + t;
          const int pq = ((const int*)ptab_get(PTAB, 2))[r];
          float q[32], o[32];
#pragma unroll
          for (int d = 0; d < 32; ++d) { q[d] = bf2f(PROJ[r * IN_COLS + C_SWQ + h * 64 + half * 32 + d]) * 0.125f; o[d] = 0.f; }
          float mrun = ((const float*)ptab_get(PTAB, 10))[l * 4 + h], lrun = 1.f;
          float* sK = sm; float* sV = sm + 1024; int* sP = (int*)(sm + 2048);
          int k0 = qb * 256 - 127; if (k0 < 0) k0 = 0;
          for (int kt = k0 / 16; kt <= (qb * 256 + 255) / 16; ++kt) {
            __syncthreads();
            for (int e = tid; e < 1024; e += NT) { const int j = e >> 6, d = e & 63; const bf16_t* pr = PROJ + ((size_t)b * SEQ + kt * 16 + j) * IN_COLS;
              sK[e] = bf2f(pr[C_SWK + kvh * 64 + d]); sV[e] = bf2f(pr[C_SWV + kvh * 64 + d]); }
            if (tid < 16) sP[tid] = ((const int*)ptab_get(PTAB, 2))[(size_t)b * SEQ + kt * 16 + tid];
            __syncthreads();
#pragma unroll 1
            for (int j = 0; j < 16; ++j) { float a = 0.f;
#pragma unroll
              for (int d = 0; d < 32; ++d) a += q[d] * sK[j * 64 + half * 32 + d];
              a += __shfl_xor(a, 1);
              const int key = kt * 16 + j; const bool valid = (key <= t) && (key >= t - 127);
              a += ((const float*)ptab_get(PTAB, 3))[rel_bucket(pq - sP[j]) * 4 + h];
              if (valid) {
                const float mn = fmaxf(mrun, a), al = expf(mrun - mn), pj = expf(a - mn);
                lrun = lrun * al + pj; mrun = mn;
#pragma unroll
                for (int d = 0; d < 32; ++d) o[d] = o[d] * al + pj * sV[j * 64 + half * 32 + d];
              } }
          }
          const float inv = 1.f / lrun;
#pragma unroll
          for (int d = 0; d < 32; ++d) Y[r * DM + 256 + h * 64 + half * 32 + d] = f2bf(o[d] * inv);
        }
      }
    }
    GRID_SYNC();
    { PHASE_IDS
      pg8::Gemm g{1024, 256, 256};
      SchedBranch S{(const char*)Y, (const char*)(ws + W_BR) + (size_t)l * 4 * 1024 * 256 * 2, G, bid};
      EpiMerge E{PROJ, T, MB};
      GEMM_PHASE(EpiMerge, SchedBranch, g, S, E);
    }
    GRID_SYNC();
    { PHASE_IDS
      pg8::Gemm g{1024, 1024, 1024};
      SchedGrid S{(const char*)MB, (const char*)(ws + W_OUT) + (size_t)l * 1024 * 1024 * 2, (size_t)256 * 1024 * 2, (size_t)256 * 1024 * 2, 64, 4, G, bid};
      EpiRes E{(l == 0) ? ((const float*)ptab_get(PTAB, 0)) : (const float*)X, T};
      GEMM_PHASE(EpiRes, SchedGrid, g, S, E);
    }
    GRID_SYNC();
    { PHASE_IDS ln_rows(T, X, XB, ((const float*)ptab_get(PTAB, 14)) + (l * 3 + 0) * DM, ((const float*)ptab_get(PTAB, 15)) + (l * 3 + 0) * DM, gw, ngw, lane); }
    GRID_SYNC();
    { PHASE_IDS
      pg8::Gemm g{1024, 1024, 1024};
      SchedGrid S{(const char*)XB, (const char*)(ws + W_XQ) + (size_t)l * 256 * 1024 * 2, (size_t)256 * 1024 * 2, (size_t)256 * 1024 * 2, 64, 1, G, bid};
      EpiBf E{XQ, 256, 0.125f};
      GEMM_PHASE(EpiBf, SchedGrid, g, S, E);
    }
    GRID_SYNC();
    { PHASE_IDS
      const int rowi = tid >> 1, half = tid & 1;
      for (int u = bid; u < 256; u += G) {
        const int qb = u >> 3, bh = u & 7, b = bh >> 2, h = bh & 3;
        const size_t r = (size_t)b * SEQ + qb * 256 + rowi;
        float q[32], o[32];
#pragma unroll
        for (int d = 0; d < 32; ++d) { q[d] = bf2f(XQ[r * 256 + h * 64 + half * 32 + d]); o[d] = 0.f; }
        float mrun = -1e30f, lrun = 0.f;
        float* sK = sm; float* sV = sm + 1024;
        for (int kt = 0; kt < 16; ++kt) {
          __syncthreads();
          for (int e = tid; e < 1024; e += NT) { const int j = e >> 6, d = e & 63; const float* kr = KVMEM + (size_t)(b * 256 + kt * 16 + j) * 512;
            sK[e] = kr[h * 64 + d]; sV[e] = kr[256 + h * 64 + d]; }
          __syncthreads();
#pragma unroll 1
          for (int j = 0; j < 16; ++j) { float a = 0.f;
#pragma unroll
            for (int d = 0; d < 32; ++d) a += q[d] * sK[j * 64 + half * 32 + d];
            a += __shfl_xor(a, 1);
            const float mn = fmaxf(mrun, a), al = expf(mrun - mn), pj = expf(a - mn);
            lrun = lrun * al + pj; mrun = mn;
#pragma unroll
            for (int d = 0; d < 32; ++d) o[d] = o[d] * al + pj * sV[j * 64 + half * 32 + d]; }
        }
        const float inv = 1.f / lrun;
#pragma unroll
        for (int d = 0; d < 32; ++d) XO[r * 256 + h * 64 + half * 32 + d] = f2bf(o[d] * inv);
        __syncthreads();
      }
    }
    GRID_SYNC();
    { PHASE_IDS
      pg8::Gemm g{256, 256, 256};
      SchedGrid S{(const char*)XO, (const char*)(ws + W_XO) + (size_t)l * 1024 * 256 * 2, (size_t)256 * 256 * 2, (size_t)256 * 256 * 2, 64, 4, G, bid};
      EpiRes E{X, T};
      GEMM_PHASE(EpiRes, SchedGrid, g, S, E);
    }
    GRID_SYNC();
    { PHASE_IDS ln_rows(T, X, XB, ((const float*)ptab_get(PTAB, 14)) + (l * 3 + 1) * DM, ((const float*)ptab_get(PTAB, 15)) + (l * 3 + 1) * DM, gw, ngw, lane); }
    GRID_SYNC();
    if (l == 0) {
      { PHASE_IDS
        pg8::Gemm g{1024, 1024, 1024};
        SchedGrid S{(const char*)XB, (const char*)(ws + W_F13), (size_t)256 * 1024 * 2, (size_t)256 * 1024 * 2, 64, 22, G, bid};
        EpiSwiGLU E{H2, F_DENSE};
        GEMM_PHASE(EpiSwiGLU, SchedGrid, g, S, E);
      }
      GRID_SYNC();
      { PHASE_IDS
        pg8::Gemm g{F_DENSE, F_DENSE, F_DENSE};
        SchedGrid S{(const char*)H2, (const char*)(ws + W_F2), (size_t)256 * F_DENSE * 2, (size_t)256 * F_DENSE * 2, 64, 4, G, bid};
        EpiRes E{X, T};
        GEMM_PHASE(EpiRes, SchedGrid, g, S, E);
      }
      GRID_SYNC();
      { PHASE_IDS ln_rows(T, X, XB, ((const float*)ptab_get(PTAB, 14)) + (l * 3 + 2) * DM, ((const float*)ptab_get(PTAB, 15)) + (l * 3 + 2) * DM, gw, ngw, lane); }
      GRID_SYNC();
    } else {
      { PHASE_IDS
        for (int r = gw; r < M; r += ngw) {
          float lg[8];
#pragma unroll
          for (int e = 0; e < 8; ++e) lg[e] = 0.f;
          for (int j = 0; j < 16; ++j) { const int k = lane + 64 * j; const float xv = X[(size_t)r * DM + k];
            const f32x4 w0 = *(const f32x4*)(((const float*)ptab_get(PTAB, 21)) + (size_t)k * 8), w1 = *(const f32x4*)(((const float*)ptab_get(PTAB, 21)) + (size_t)k * 8 + 4);
            lg[0] += xv * w0[0]; lg[1] += xv * w0[1]; lg[2] += xv * w0[2]; lg[3] += xv * w0[3]; lg[4] += xv * w1[0]; lg[5] += xv * w1[1]; lg[6] += xv * w1[2]; lg[7] += xv * w1[3]; }
#pragma unroll
          for (int e = 0; e < 8; ++e) lg[e] = wave_sum(lg[e]);
          int e0 = 0; float v0 = lg[0];
#pragma unroll
          for (int e = 1; e < 8; ++e) if (lg[e] > v0) { v0 = lg[e]; e0 = e; }
          int e1 = -1; float v1 = -3.0e38f;
#pragma unroll
          for (int e = 0; e < 8; ++e) if (e != e0 && lg[e] > v1) { v1 = lg[e]; e1 = e; }
          if (lane == 0) {
            const float w1_ = 1.f / (1.f + expf(v0 - v1)), w0_ = 1.f - w1_;
            const int p0 = (int)atomicAdd(ctl + CW_CNT + e0, 1u), p1 = (int)atomicAdd(ctl + CW_CNT + e1, 1u);
            tok_e[2 * r] = e0; tok_e[2 * r + 1] = e1; tok_p[2 * r] = p0; tok_p[2 * r + 1] = p1; tok_w[2 * r] = w0_; tok_w[2 * r + 1] = w1_;
          }
        }
      }
      GRID_SYNC();
      int pstart[9];
      { PHASE_IDS
        int cnt[8]; int a = 0;
#pragma unroll
        for (int e = 0; e < 8; ++e) { pstart[e] = a; cnt[e] = __builtin_amdgcn_readfirstlane((int)__hip_atomic_load(ctl + CW_CNT + e, __ATOMIC_RELAXED, __HIP_MEMORY_SCOPE_AGENT)); a += (cnt[e] + 255) / 256 * 256; }
        pstart[8] = a;
        for (int i = gw; i < 2 * M; i += ngw) { const int e = tok_e[i];
          int st = 0;
#pragma unroll
          for (int q = 0; q < 8; ++q) if (q == e) st = pstart[q];
          const int dest = st + tok_p[i]; if (lane == 0) tok_slot[i] = dest;
          const u32x4* src = (const u32x4*)(XB + (size_t)(i >> 1) * DM); u32x4* dst = (u32x4*)(XG + (size_t)dest * DM);
          dst[lane] = src[lane]; dst[lane + 64] = src[lane + 64]; }
        for (int e = 0; e < 8; ++e) { const int r0 = pstart[e] + cnt[e], r1 = pstart[e + 1];
          for (int rr = r0 + gw; rr < r1; rr += ngw) { u32x4* dst = (u32x4*)(XG + (size_t)rr * DM); dst[lane] = (u32x4){0u, 0u, 0u, 0u}; dst[lane + 64] = (u32x4){0u, 0u, 0u, 0u}; } }
      }
      GRID_SYNC();
      { PHASE_IDS
        pg8::Gemm g{1024, 1024, 1024};
        SchedMoE S{(const char*)XG, (const char*)(ws + W_M13), (size_t)256 * 1024 * 2, (size_t)256 * 1024 * 2, (size_t)2 * F_EXP * 1024 * 2, pstart[8] / 256, 28, G, bid,
                   pstart[1], pstart[2], pstart[3], pstart[4], pstart[5], pstart[6], pstart[7]};
        EpiSwiGLU E{H2, F_EXP};
        GEMM_PHASE(EpiSwiGLU, SchedMoE, g, S, E);
      }
      GRID_SYNC();
      { PHASE_IDS
        pg8::Gemm g{F_EXP, F_EXP, F_EXP};
        SchedMoE S{(const char*)H2, (const char*)(ws + W_M2), (size_t)256 * F_EXP * 2, (size_t)256 * F_EXP * 2, (size_t)1024 * F_EXP * 2, pstart[8] / 256, 4, G, bid,
                   pstart[1], pstart[2], pstart[3], pstart[4], pstart[5], pstart[6], pstart[7]};
        EpiF32 E{YS};
        GEMM_PHASE(EpiF32, SchedMoE, g, S, E);
      }
      GRID_SYNC();
      { PHASE_IDS
        const float* g = ((const float*)ptab_get(PTAB, 14)) + (l * 3 + 2) * DM; const float* bb_ = ((const float*)ptab_get(PTAB, 15)) + (l * 3 + 2) * DM;
        for (int r = gw; r < M; r += ngw) {
          const int s0 = tok_slot[2 * r], s1 = tok_slot[2 * r + 1]; const float w0 = tok_w[2 * r], w1 = tok_w[2 * r + 1];
          f32x4 v[4]; float s = 0.f;
#pragma unroll
          for (int j = 0; j < 4; ++j) { const f32x4 xv = ((const f32x4*)(X + (size_t)r * DM))[lane + 64 * j];
            const f32x4 y0 = ((const f32x4*)(YS + (size_t)s0 * DM))[lane + 64 * j], y1 = ((const f32x4*)(YS + (size_t)s1 * DM))[lane + 64 * j];
            v[j] = xv * ALPHA + y0 * w0 + y1 * w1; s += (v[j][0] + v[j][1]) + (v[j][2] + v[j][3]); }
          const float mean = wave_sum(s) * (1.f / DM); float s2 = 0.f;
#pragma unroll
          for (int j = 0; j < 4; ++j) { v[j] = v[j] - mean; s2 += (v[j][0] * v[j][0] + v[j][1] * v[j][1]) + (v[j][2] * v[j][2] + v[j][3] * v[j][3]); }
          const float rstd = rsqrtf(wave_sum(s2) * (1.f / DM) + EPS);
          f32x4* o = (f32x4*)(((float*)ptab_get(PTAB, 24)) + (size_t)r * DM) + lane;
#pragma unroll
          for (int j = 0; j < 4; ++j) { const f32x4 gg = ((const f32x4*)g)[lane + 64 * j], bv = ((const f32x4*)bb_)[lane + 64 * j]; o[64 * j] = v[j] * rstd * gg + bv; }
        }
      }
    }
  }
}

#undef ctl
#undef X
#undef T
#undef XB
#undef Y
#undef MB
#undef QM
#undef KM
#undef VM
#undef CQN
#undef CKVN
#undef XQ
#undef XO
#undef ROPE
#undef KVMEM
#undef PROJ
#undef H2
#undef YS
#undef XG
constexpr int LDS_BYTES = 147456;
extern "C" void kernel_launch(void* const* d_in, const int* in_sizes, int n_in, void* d_out, int out_size, void* d_ws, size_t ws_size, hipStream_t stream) {
  static int grid = 0;
  if (grid == 0) {
    int dev = 0, cus = 0, per_cu = 0;
    (void)hipGetDevice(&dev);
    (void)hipDeviceGetAttribute(&cus, hipDeviceAttributeMultiprocessorCount, dev);
    (void)hipFuncSetAttribute((const void*)mega, hipFuncAttributeMaxDynamicSharedMemorySize, LDS_BYTES);
    (void)hipOccupancyMaxActiveBlocksPerMultiprocessor(&per_cu, (const void*)mega, NT, LDS_BYTES);
    if (per_cu < 1) { fprintf(stderr, "occupancy query says %d blocks/CU\n", per_cu); per_cu = 1; }
    if (per_cu > 1) per_cu = 1;
    grid = cus * per_cu;
    if (ws_size < WS_END) { fprintf(stderr, "workspace too small: %zu < %zu\n", ws_size, (size_t)WS_END); grid = -1; }
  }
  if (grid < 0) return;
  (void)hipMemsetAsync((char*)d_ws + WS_CTL, 0, 1 * MiB, stream);
  Params p{};
  const float** f = (const float**)&p;
  for (int i = 0; i < 24; ++i) f[i] = (const float*)d_in[i];
  p.pos = (const int*)d_in[2];
  p.out = (float*)d_out; p.ws = (unsigned char*)d_ws;
  void* args[] = {&p};
  hipError_t e = hipLaunchCooperativeKernel((const void*)mega, dim3(grid), dim3(NT), args, LDS_BYTES, stream);
  if (e != hipSuccess) fprintf(stderr, "cooperative launch failed: %s (grid %d)\n", hipGetErrorString(e), grid);
}
```

```cpp
#include <hip/hip_runtime.h>
#include <hip/hip_cooperative_groups.h>
#include <cstdio>
#include <cstdint>
namespace cg = cooperative_groups;

namespace pg8 {
#define PG8_LAS __attribute__((address_space(3)))
typedef unsigned short bf16_t;
typedef short bf16x8 __attribute__((ext_vector_type(8)));
typedef float f32x4 __attribute__((ext_vector_type(4)));
typedef unsigned u32x4 __attribute__((ext_vector_type(4)));
constexpr int BM = 256, BK = 64, HALF = 128, HTB = HALF * BK * 2  , STAGE_BYTES = 8 * HTB, NXCD = 8, WGM = 8;

__host__ __device__ __forceinline__ int lds_byte(int r, int c) { const int st = (r >> 4) * 2 + (c >> 5), rr = r & 15, cc = c & 31, ob = rr * 64 + cc * 2; return st * 1024 + (ob ^ (((ob >> 9) & 1) << 5)); }
__host__ __device__ __forceinline__ void stage_rc(int b, int& R, int& C) { const int st = b / 1024, sb = b % 1024, swz = sb ^ (((sb >> 9) & 1) << 5); R = (st >> 1) * 16 + swz / 64; C = (st & 1) * 32 + (swz % 64) / 2; }
__host__ __device__ __forceinline__ int perm32(int rho) { const int n = rho >> 4, i = rho & 15; return 8 * (i >> 2) + 4 * n + (i & 3); }


struct Unit { int pm, pn; const char* a; const char* b; int aux; };
struct Gemm { int lda, ldb, K; };
__device__ __forceinline__ void glds16_s(const void* sbase, unsigned voff, unsigned lds_dst) { unsigned keep;
  asm volatile("s_mov_b32 %0, m0\n\ts_mov_b32 m0, %3\n\ts_nop 0\n\tglobal_load_lds_dwordx4 %2, %1\n\ts_mov_b32 m0, %0" : "=&s"(keep) : "s"(sbase), "v"(voff), "s"(lds_dst) : "memory"); }
__device__ __forceinline__ const char* uni_ptr(const char* q) { const unsigned long long v = (unsigned long long)(uintptr_t)q;
  const unsigned lo = __builtin_amdgcn_readfirstlane((unsigned)v), hi = __builtin_amdgcn_readfirstlane((unsigned)(v >> 32)); return (const char*)(uintptr_t)(((unsigned long long)hi << 32) | lo); }
__device__ __forceinline__ unsigned cvt_pk_bf16(float lo, float hi) { unsigned r; asm volatile("v_cvt_pk_bf16_f32 %0, %1, %2" : "=v"(r) : "v"(lo), "v"(hi)); return r; }
template <class Epi, class Sched, bool ALIGN_EPI = false, bool SP2 = false>
__device__ __forceinline__ void gemm_phase(PG8_LAS unsigned char* lds, const Gemm g, const Sched& S, const Epi& E, const int tid_in) {
    int tid_l = tid_in; asm volatile("" : "+v"(tid_l));
    const int tid = tid_l, wid = __builtin_amdgcn_readfirstlane(tid >> 6), lane = tid & 63, wr = wid >> 2, wc = wid & 3, fr = lane & 15, fq = lane >> 4;
    const int K = g.K, nt = K / BK;
    unsigned voffA[2], voffB[2];
#pragma unroll
    for (int i = 0; i < 2; ++i) { int R, C; stage_rc(tid * 16 + i * 8192, R, C); const int Rb = Epi::PERM ? ((R & ~31) + perm32(R & 31)) : R;
        voffA[i] = (unsigned)(R * g.lda + C) * 2u; voffB[i] = (unsigned)(Rb * g.ldb + C) * 2u; }
    const size_t kstep = (size_t)(BK * 2);
    const size_t hstepA = (size_t)HALF * g.lda * 2, hstepB = (size_t)HALF * g.ldb * 2;
    const unsigned ldsb = (unsigned)(uintptr_t)lds;
    const unsigned ldsw = (unsigned)wid * 1024u;
    const int aoff = lds_byte(wr * 64 + fr, fq * 8), boff = lds_byte(wc * 32 + fr, fq * 8);
#define PG8_SA(b, h) (((b) * 2 + (h)) * HTB)
#define PG8_SB(b, h) ((4 + (b) * 2 + (h)) * HTB)
#define PG8_STAGE(bufoff, gbase, voff) do { _Pragma("unroll") for (int _i = 0; _i < 2; ++_i) \
        glds16_s((const void*)(gbase), (voff)[_i], (unsigned)__builtin_amdgcn_readfirstlane((int)(ldsb + (unsigned)(bufoff) + ldsw + (unsigned)(_i * 8192)))); } while (0)
#define PG8_LDA(dst, b, h) do { _Pragma("unroll") for (int m = 0; m < 4; ++m) _Pragma("unroll") for (int k = 0; k < 2; ++k) dst[m][k] = *(const PG8_LAS bf16x8*)(lds + PG8_SA(b, h) + aoff + m * 2048 + k * 1024); } while (0)
#define PG8_LDB(dst, b, h) do { _Pragma("unroll") for (int n = 0; n < 2; ++n) _Pragma("unroll") for (int k = 0; k < 2; ++k) dst[n][k] = *(const PG8_LAS bf16x8*)(lds + PG8_SB(b, h) + boff + n * 2048 + k * 1024); } while (0)
#define PG8_MMA(ai, bj, At, Bt) do { __builtin_amdgcn_s_setprio(1); _Pragma("unroll") for (int m = 0; m < 4; ++m) _Pragma("unroll") for (int n = 0; n < 2; ++n) _Pragma("unroll") for (int k = 0; k < 2; ++k) \
        acc[ai][bj][m][n] = __builtin_amdgcn_mfma_f32_16x16x32_bf16(Bt[n][k], At[m][k], acc[ai][bj][m][n], 0, 0, 0); __builtin_amdgcn_s_setprio(0); } while (0)
#define PG8_WAIT_V(n) asm volatile("s_waitcnt vmcnt(" #n ")" ::: "memory")
#define PG8_WAIT_L(n) asm volatile("s_waitcnt lgkmcnt(" #n ")" ::: "memory")
#define PG8_BAR __builtin_amdgcn_s_barrier()
#define PG8_SCHED __builtin_amdgcn_sched_barrier(0)
    Unit cur, nxt; int ui = 0;
    if (!S.next(0, cur)) return;
    f32x4 acc[2][2][4][2];
#pragma unroll
    for (int a = 0; a < 2; ++a)
#pragma unroll
        for (int b = 0; b < 2; ++b)
#pragma unroll
            for (int m = 0; m < 4; ++m)
#pragma unroll
                for (int n = 0; n < 2; ++n) acc[a][b][m][n] = (f32x4){0.f, 0.f, 0.f, 0.f};
    bf16x8 At[4][2], B0[2][2], B1[2][2];
    const char* cA = uni_ptr(cur.a); const char* cB = uni_ptr(cur.b);
    S.a_ready(cur);
    if constexpr (SP2) {
        PG8_STAGE(PG8_SB(0, 0), cB, voffB); PG8_STAGE(PG8_SB(0, 1), cB + hstepB, voffB); PG8_STAGE(PG8_SA(0, 0), cA, voffA); PG8_STAGE(PG8_SA(0, 1), cA + hstepA, voffA);
        if (wr == 1) PG8_BAR;
        PG8_WAIT_V(2); PG8_BAR;
        PG8_STAGE(PG8_SB(1, 0), cB + kstep, voffB); PG8_STAGE(PG8_SA(1, 0), cA + kstep, voffA); PG8_STAGE(PG8_SB(1, 1), cB + hstepB + kstep, voffB);
        PG8_WAIT_V(6); PG8_BAR;
    } else {
        PG8_STAGE(PG8_SB(0, 0), cB, voffB); PG8_STAGE(PG8_SA(0, 0), cA, voffA); PG8_STAGE(PG8_SB(0, 1), cB + hstepB, voffB); PG8_STAGE(PG8_SA(0, 1), cA + hstepA, voffA);
        if (wr == 1) PG8_BAR;
        PG8_WAIT_V(4); PG8_BAR;
        PG8_STAGE(PG8_SB(1, 0), cB + kstep, voffB); PG8_STAGE(PG8_SA(1, 0), cA + kstep, voffA); PG8_STAGE(PG8_SB(1, 1), cB + hstepB + kstep, voffB);
        PG8_WAIT_V(6); PG8_BAR;
    }
    for (;;) {
        const bool has_next = S.next(ui + 1, nxt);
        const char* nA = has_next ? uni_ptr(nxt.a) : cA; const char* nB = has_next ? uni_ptr(nxt.b) : cB;
#pragma nounroll
        for (int t = 0; t < nt; t += 2) {
            const bool last = (t == nt - 2);
            const char* a1 = cA + (size_t)(t + 1) * kstep;
            const char* a2 = last ? nA : cA + (size_t)(t + 2) * kstep; const char* b2 = last ? nB : cB + (size_t)(t + 2) * kstep;
            const char* a3 = a2 + kstep; const char* b3 = b2 + kstep;
            if (last && has_next) S.a_ready(nxt);
            if constexpr (SP2) {
            PG8_LDB(B0, 0, 0); PG8_LDB(B1, 0, 1); PG8_SCHED; PG8_LDA(At, 0, 0); PG8_STAGE(PG8_SA(1, 1), a1 + hstepA, voffA);
            PG8_WAIT_V(8); PG8_WAIT_L(0); PG8_BAR; PG8_MMA(0, 0, At, B0); PG8_MMA(0, 1, At, B1); PG8_BAR; PG8_SCHED;
            PG8_LDA(At, 0, 1); PG8_STAGE(PG8_SB(0, 0), b2, voffB); PG8_STAGE(PG8_SB(0, 1), b2 + hstepB, voffB); PG8_STAGE(PG8_SA(0, 0), a2, voffA);
            PG8_WAIT_V(8); PG8_WAIT_L(0); PG8_BAR; PG8_MMA(1, 0, At, B0); PG8_MMA(1, 1, At, B1); PG8_BAR; PG8_SCHED;
            PG8_LDB(B0, 1, 0); PG8_LDB(B1, 1, 1); PG8_SCHED; PG8_LDA(At, 1, 0); PG8_STAGE(PG8_SA(0, 1), a2 + hstepA, voffA);
            PG8_WAIT_V(8); PG8_WAIT_L(0); PG8_BAR; PG8_MMA(0, 0, At, B0); PG8_MMA(0, 1, At, B1); PG8_BAR; PG8_SCHED;
            PG8_LDA(At, 1, 1); PG8_STAGE(PG8_SB(1, 0), b3, voffB); PG8_STAGE(PG8_SB(1, 1), b3 + hstepB, voffB); PG8_STAGE(PG8_SA(1, 0), a3, voffA);
            PG8_WAIT_V(8); PG8_WAIT_L(0); PG8_BAR; PG8_MMA(1, 0, At, B0); PG8_MMA(1, 1, At, B1); PG8_BAR; PG8_SCHED;
            } else {
            PG8_LDB(B0, 0, 0); PG8_SCHED; PG8_LDA(At, 0, 0); PG8_STAGE(PG8_SA(1, 1), a1 + hstepA, voffA);
            PG8_WAIT_L(8); PG8_BAR; PG8_WAIT_L(0); PG8_MMA(0, 0, At, B0); PG8_BAR; PG8_SCHED;
            PG8_LDB(B1, 0, 1); PG8_STAGE(PG8_SB(0, 0), b2, voffB);
            PG8_BAR; PG8_WAIT_L(0); PG8_MMA(0, 1, At, B1); PG8_BAR;
            PG8_LDA(At, 0, 1); PG8_STAGE(PG8_SA(0, 0), a2, voffA);
            PG8_BAR; PG8_WAIT_L(0); PG8_MMA(1, 0, At, B0); PG8_BAR; PG8_SCHED;
            PG8_STAGE(PG8_SB(0, 1), b2 + hstepB, voffB);
            PG8_WAIT_V(6); PG8_BAR; PG8_MMA(1, 1, At, B1); PG8_BAR;
            PG8_LDB(B0, 1, 0); PG8_SCHED; PG8_LDA(At, 1, 0); PG8_STAGE(PG8_SA(0, 1), a2 + hstepA, voffA);
            PG8_WAIT_L(8); PG8_BAR; PG8_WAIT_L(0); PG8_MMA(0, 0, At, B0); PG8_BAR; PG8_SCHED;
            PG8_LDB(B1, 1, 1); PG8_STAGE(PG8_SB(1, 0), b3, voffB);
            PG8_BAR; PG8_WAIT_L(0); PG8_MMA(0, 1, At, B1); PG8_BAR;
            PG8_LDA(At, 1, 1); PG8_STAGE(PG8_SA(1, 0), a3, voffA);
            PG8_BAR; PG8_WAIT_L(0); PG8_MMA(1, 0, At, B0); PG8_BAR; PG8_SCHED;
            PG8_STAGE(PG8_SB(1, 1), b3 + hstepB, voffB);
            PG8_WAIT_V(6); PG8_BAR; PG8_MMA(1, 1, At, B1); PG8_BAR;
            }
        }
        if constexpr (ALIGN_EPI) { if (wr == 0) PG8_BAR; }
        if constexpr (!Epi::AFTER_DRAIN) { E(acc, cur, wr, wc, fr, fq); S.done(cur); }
        if (!has_next) break;
#pragma unroll
        for (int a = 0; a < 2; ++a)
#pragma unroll
            for (int b = 0; b < 2; ++b)
#pragma unroll
                for (int m = 0; m < 4; ++m)
#pragma unroll
                    for (int n = 0; n < 2; ++n) acc[a][b][m][n] = (f32x4){0.f, 0.f, 0.f, 0.f};
        cur = nxt; cA = nA; cB = nB; ++ui;
        if constexpr (ALIGN_EPI) { if (wr == 1) PG8_BAR; }
    }
    PG8_WAIT_V(0);
    if constexpr (!ALIGN_EPI) { if (wr == 0) PG8_BAR; }
    PG8_BAR;
    if constexpr (Epi::AFTER_DRAIN) { E.fused(acc, cur, wr, wc, fr, fq, lds, wid, lane); S.done(cur); }
#undef PG8_SA
#undef PG8_SB
#undef PG8_STAGE
#undef PG8_LDA
#undef PG8_LDB
#undef PG8_MMA
#undef PG8_WAIT_V
#undef PG8_WAIT_L
#undef PG8_BAR
#undef PG8_SCHED
}
}

typedef unsigned short bf16_t;
typedef float f32x4 __attribute__((ext_vector_type(4)));
typedef unsigned u32x4 __attribute__((ext_vector_type(4)));
typedef unsigned u32x2 __attribute__((ext_vector_type(2)));
#define LAS __attribute__((address_space(3)))

constexpr int DM = 1024, BATCH = 2, SEQ = 8192, M = BATCH * SEQ, DEPTH = 2, MEMLEN = 256;
constexpr int IN_COLS = 6816, IN_PAD = 6912;
constexpr int C_CQ = 0, C_CKV = 256, C_KR = 384, C_SWQ = 416, C_SWK = 672, C_SWV = 800, C_HQ = 928, C_HF = 1184, C_HI = 1440, C_HG = 1696,
              C_SBQ = 1952, C_SBK = 2208, C_SBV = 2464, C_GATE = 2720;
constexpr int F_DENSE = 2816, F_EXP = 3584, NEXP = 8;
constexpr int CAP = 2 * M + NEXP * 256;
constexpr float EPS = 1e-5f;
constexpr float ALPHA = 1.4142135623730951f;
constexpr int NT = 512;

constexpr size_t MiB = 1u << 20;
constexpr size_t WS_CTL = 0;
constexpr size_t WS_X = 1 * MiB;
constexpr size_t WS_T = WS_X + 64 * MiB;
constexpr size_t WS_XB = WS_T + 64 * MiB;
constexpr size_t WS_RA = WS_XB + 32 * MiB;
constexpr size_t WS_Y = WS_RA;
constexpr size_t WS_MB = WS_Y + 32 * MiB;
constexpr size_t WS_QM = WS_MB + 32 * MiB;
constexpr size_t WS_KM = WS_QM + 12 * MiB;
constexpr size_t WS_VM = WS_KM + 12 * MiB;
constexpr size_t WS_CQN = WS_VM + 8 * MiB;
constexpr size_t WS_CKVN = WS_CQN + 8 * MiB;
constexpr size_t WS_XQ = WS_CKVN + 8 * MiB;
constexpr size_t WS_XO = WS_XQ + 8 * MiB;
constexpr size_t WS_ROPE = WS_XO + 8 * MiB;
constexpr size_t WS_YS = WS_RA;
constexpr size_t WS_RA_END = WS_RA + 136 * MiB;
static_assert(WS_ROPE + 2 * MiB <= WS_RA_END, "region A");
constexpr size_t WS_KVMEM = WS_RA_END;
constexpr size_t WS_ROUTE = WS_KVMEM + 1 * MiB;
constexpr size_t WS_XG = WS_ROUTE + 4 * MiB;
constexpr size_t WS_HGH = WS_XG, WS_HGS = WS_XG + 16 * MiB, WS_HGB = WS_XG + 32 * MiB, WS_HGD = WS_XG + 48 * MiB;
constexpr size_t WS_BIG = WS_XG + 68 * MiB;
constexpr size_t WS_W = WS_BIG + 238 * MiB;
constexpr size_t W_IN = WS_W;
constexpr size_t W_UQ = W_IN + (size_t)2 * IN_PAD * 1024 * 2;
constexpr size_t W_UKV = W_UQ + (size_t)2 * 512 * 256 * 2;
constexpr size_t W_BR = W_UKV + (size_t)2 * 512 * 256 * 2;
constexpr size_t W_OUT = W_BR + (size_t)2 * 4 * 1024 * 256 * 2;
constexpr size_t W_XQ = W_OUT + (size_t)2 * 1024 * 1024 * 2;
constexpr size_t W_XO = W_XQ + (size_t)2 * 256 * 1024 * 2;
constexpr size_t W_F13 = W_XO + (size_t)2 * 1024 * 256 * 2;
constexpr size_t W_F2 = W_F13 + (size_t)5632 * 1024 * 2;
constexpr size_t W_M13 = W_F2 + (size_t)1024 * 2816 * 2;
constexpr size_t W_M2 = W_M13 + (size_t)8 * 7168 * 1024 * 2;
constexpr size_t WS_END = W_M2 + (size_t)8 * 1024 * 3584 * 2;
static_assert(WS_END <= (size_t)896 * MiB, "workspace");

constexpr int CW_CNT = 0;
constexpr int CW_UNIT = 64;
constexpr int CW_BAR = 4096;

struct Params {
  const float* x; const float* mem; const int* pos; const float* rel; const float* lbl; const float* w_in;
  const float* qnorm; const float* w_uq; const float* kvnorm; const float* w_ukv; const float* sinks; const float* hnorm;
  const float* w_branch; const float* w_out; const float* ln_g; const float* ln_b; const float* xa_wq; const float* xa_wkv; const float* xa_wo;
  const float* ffn_w13; const float* ffn_w2; const float* router; const float* moe_w13; const float* moe_w2;
  float* out; unsigned char* ws;
};

__device__ __forceinline__ float bf2f(bf16_t v) { return __uint_as_float((unsigned)v << 16); }
__device__ __forceinline__ bf16_t f2bf(float f) { unsigned u = __float_as_uint(f); return (bf16_t)((u + 0x7fffu + ((u >> 16) & 1u)) >> 16); }
__device__ __forceinline__ unsigned pk2(float lo, float hi) { return (unsigned)f2bf(lo) | ((unsigned)f2bf(hi) << 16); }
__device__ __forceinline__ float ldf(const float* p, size_t i) { return p[i]; }
__device__ __forceinline__ float ldf(const bf16_t* p, size_t i) { return bf2f(p[i]); }
__device__ __forceinline__ float sigmoidf_(float x) { return 1.0f / (1.0f + expf(-x)); }
__device__ __forceinline__ float siluf_(float x) { return x / (1.0f + expf(-x)); }
__device__ __forceinline__ float fast_sigmoid(float x) { return __builtin_amdgcn_rcpf(1.0f + __builtin_amdgcn_exp2f(-1.4426950408889634f * x)); }
__device__ __forceinline__ float logsigf_(float z) { return fminf(z, 0.0f) - log1pf(expf(-fabsf(z))); }
__device__ __forceinline__ float wave_sum(float v) {
#pragma unroll
  for (int o = 1; o < 64; o <<= 1) v += __shfl_xor(v, o);
  return v;
}
__device__ __forceinline__ int rel_bucket(int d) {
  int n = d > 0 ? d : 0;
  if (n < 16) return n;
  float nf = (float)n;
  int large = 16 + (int)(logf(nf / 16.0f) / 2.0794415416798357f * 16.0f);
  large = large < 0 ? 0 : (large > 31 ? 31 : large);
  return large;
}
__device__ const float INV_FREQ[16] = {1.0f, 0.5623413251903491f, 0.31622776601683794f, 0.1778279410038923f, 0.1f, 0.05623413251903491f, 0.031622776601683794f,
  0.01778279410038923f, 0.01f, 0.005623413251903491f, 0.0031622776601683794f, 0.001778279410038923f, 0.001f, 0.0005623413251903491f,
  0.00031622776601683794f, 0.0001778279410038923f};
__device__ __forceinline__ void sincos_big(float ang, float& s, float& c) {
  double rev = (double)ang * 0.15915494309189535;
  rev = rev - rint(rev);
  float fr = (float)rev;
  s = __builtin_amdgcn_sinf(fr); c = __builtin_amdgcn_cosf(fr);
}
__device__ __forceinline__ void* ptab_get(LAS const unsigned long long* tab, int i) {
  const unsigned long long v = tab[i]; const unsigned lo = __builtin_amdgcn_readfirstlane((unsigned)v), hi = __builtin_amdgcn_readfirstlane((unsigned)(v >> 32));
  return (void*)(uintptr_t)(((unsigned long long)hi << 32) | lo); }
__device__ __forceinline__ int launder(int v) { asm volatile("" : "+v"(v)); return v; }
__device__ __forceinline__ int launder_s(int v) { asm volatile("" : "+s"(v)); return v; }
__device__ __forceinline__ LAS unsigned char* launder_lds(LAS unsigned char* q) { unsigned v = (unsigned)(uintptr_t)q; asm volatile("" : "+s"(v)); return (LAS unsigned char*)(uintptr_t)v; }
#define PHASE_IDS const int bid = launder_s(bid0), G = launder_s(G0), ngw = G * 8; LAS unsigned char* lds3 = launder_lds(lds30); \
  LAS const unsigned long long* PTAB = (LAS const unsigned long long*)(lds3 + 131072 + 1024); unsigned char* ws = (unsigned char*)ptab_get(PTAB, 25); \
  const int tid = launder(launder_s(wave0) * 64 + (int)__builtin_amdgcn_mbcnt_hi(~0u, __builtin_amdgcn_mbcnt_lo(~0u, 0u))), lane = tid & 63, wave = tid >> 6, gw = bid * 8 + wave, ty = tid >> 4, tx = tid & 15; (void)lane; (void)wave; (void)gw; (void)ty; (void)tx; (void)ngw; (void)ws;

template <typename TA, bool DUAL>
__device__ __forceinline__ void tile_mm(float (&acc)[4][8], float (&acc2)[4][8], const TA* A, int lda, const int* ridx, int row0,
                                        const float* B, const float* B2, int ldb, int col0, int N, int K, float* sm, const int tid_in) {
  float* sA = sm; float* sB = sm + 16 * 132; float* sB2 = sm + 32 * 132;
  const int tid = launder(tid_in), ty = tid >> 4, tx = tid & 15;
  const int ar = tid >> 2, ak = (tid & 3) * 4;
  const int bk = tid >> 5, bc = (tid & 31) * 4;
  long arow = ridx ? (long)ridx[row0 + ar] : (long)(row0 + ar);
#pragma unroll
  for (int i = 0; i < 4; ++i)
#pragma unroll
    for (int j = 0; j < 8; ++j) { acc[i][j] = 0.f; acc2[i][j] = 0.f; }
  const bool bval = (col0 + bc) < N;
  for (int k0 = 0; k0 < K; k0 += 16) {
    float a0 = 0.f, a1 = 0.f, a2 = 0.f, a3 = 0.f;
    if (arow >= 0) { const size_t o = (size_t)arow * lda + k0 + ak; a0 = ldf(A, o); a1 = ldf(A, o + 1); a2 = ldf(A, o + 2); a3 = ldf(A, o + 3); }
    f32x4 b = {0.f, 0.f, 0.f, 0.f}, b2 = {0.f, 0.f, 0.f, 0.f};
    if (bval) { b = *(const f32x4*)(B + (size_t)(k0 + bk) * ldb + col0 + bc); if (DUAL) b2 = *(const f32x4*)(B2 + (size_t)(k0 + bk) * ldb + col0 + bc); }
    __syncthreads();
    sA[(ak + 0) * 132 + ar] = a0; sA[(ak + 1) * 132 + ar] = a1; sA[(ak + 2) * 132 + ar] = a2; sA[(ak + 3) * 132 + ar] = a3;
    *(f32x4*)&sB[bk * 132 + bc] = b;
    if (DUAL) *(f32x4*)&sB2[bk * 132 + bc] = b2;
    __syncthreads();
#pragma unroll 4
    for (int kk = 0; kk < 16; ++kk) {
      const f32x4 a = *(const f32x4*)&sA[kk * 132 + ty * 4];
      const f32x4 p = *(const f32x4*)&sB[kk * 132 + tx * 8], q = *(const f32x4*)&sB[kk * 132 + tx * 8 + 4];
#pragma unroll
      for (int i = 0; i < 4; ++i) {
        acc[i][0] += a[i] * p[0]; acc[i][1] += a[i] * p[1]; acc[i][2] += a[i] * p[2]; acc[i][3] += a[i] * p[3];
        acc[i][4] += a[i] * q[0]; acc[i][5] += a[i] * q[1]; acc[i][6] += a[i] * q[2]; acc[i][7] += a[i] * q[3];
      }
      if (DUAL) {
        const f32x4 p2 = *(const f32x4*)&sB2[kk * 132 + tx * 8], q2 = *(const f32x4*)&sB2[kk * 132 + tx * 8 + 4];
#pragma unroll
        for (int i = 0; i < 4; ++i) {
          acc2[i][0] += a[i] * p2[0]; acc2[i][1] += a[i] * p2[1]; acc2[i][2] += a[i] * p2[2]; acc2[i][3] += a[i] * p2[3];
          acc2[i][4] += a[i] * q2[0]; acc2[i][5] += a[i] * q2[1]; acc2[i][6] += a[i] * q2[2]; acc2[i][7] += a[i] * q2[3];
        }
      }
    }
  }
  __syncthreads();
}


#define XB_TMO      128
#define XB_XCNT(j)  (256  + 64 * (j))
#define XB_XSUB(j)  (1280 + 64 * (j))
#define XB_XGEN(j)  (2304 + 64 * (j))
#define XB_TOP      3328
#define XB_TOPGEN   3392
#define XCD_BAR_WORDS 3456
#define XB_SPIN_CAP (1u << 18)

__device__ __forceinline__ unsigned xb_ld(unsigned* p)              { return __hip_atomic_load(p, __ATOMIC_RELAXED, __HIP_MEMORY_SCOPE_AGENT); }
__device__ __forceinline__ unsigned xb_add(unsigned* p, unsigned v) { return __hip_atomic_fetch_add(p, v, __ATOMIC_RELAXED, __HIP_MEMORY_SCOPE_AGENT); }
__device__ __forceinline__ unsigned xb_xcc_id() { return (unsigned)__builtin_amdgcn_s_getreg((3 << 11) | 20) & 0xFu; }
#define XB_SPIN(cond, bar) do { unsigned _sp = 0; while (cond) { __builtin_amdgcn_s_sleep(1); \
    if ((++_sp & 255u) == 0u) { if (xb_ld(&(bar)[XB_TMO])) break; if (_sp > XB_SPIN_CAP) { atomicAdd(&(bar)[XB_TMO], 1u); break; } } } } while (0)

struct XcdBarrier {
    unsigned* bar; unsigned x;
    volatile LAS unsigned* st;
};

__device__ __forceinline__ XcdBarrier xcd_barrier_post(unsigned* bar, volatile LAS unsigned* st) {
    XcdBarrier b; b.bar = bar; b.x = xb_xcc_id(); b.st = st;
    if (threadIdx.x == 0) (void)xb_add(&bar[XB_XCNT(b.x)], 1u);
    return b;
}
__device__ __forceinline__ void xcd_barrier_complete(unsigned* bar, unsigned x, unsigned& nloc, unsigned& nx) {
    const unsigned G = gridDim.x * gridDim.y * gridDim.z;
    unsigned sum, cnt, mine, sp = 0u;
    for (;;) {
        sum = 0u; cnt = 0u; mine = 0u;
#pragma unroll
        for (unsigned j = 0; j < 16; ++j) { const unsigned c = xb_ld(&bar[XB_XCNT(j)]); sum += c; cnt += (c > 0u) ? 1u : 0u; mine = (j == x) ? c : mine; }
        if (sum == G) break;
        __builtin_amdgcn_s_sleep(1);
        if ((++sp & 255u) == 0u) { if (xb_ld(&bar[XB_TMO])) break; if (sp > XB_SPIN_CAP) { atomicAdd(&bar[XB_TMO], 1u); break; } }
    }
    nloc = mine > 0u ? mine : 1u; nx = cnt > 0u ? cnt : 1u;
}

__device__ __forceinline__ void xcd_barrier(const XcdBarrier& b, const int tid) {
    asm volatile("s_waitcnt vmcnt(0)" ::: "memory");
    __syncthreads();
    if (tid == 0) {
        unsigned* bar = b.bar;
        __builtin_amdgcn_s_waitcnt(0);
        unsigned nloc = b.st[0], nx = b.st[1];
        if (nloc == 0u) { xcd_barrier_complete(bar, b.x, nloc, nx); b.st[0] = nloc; b.st[1] = nx; }
        const unsigned old = xb_add(&bar[XB_XSUB(b.x)], 1u);
        const unsigned gen = old / nloc;
        if (old + 1u == (gen + 1u) * nloc) {
            __builtin_amdgcn_fence(__ATOMIC_RELEASE, "agent");
            asm volatile("s_waitcnt vmcnt(0)" ::: "memory");
            const unsigned og = xb_add(&bar[XB_TOP], 1u);
            const unsigned tg = og / nx;
            if (og + 1u == (tg + 1u) * nx) xb_add(&bar[XB_TOPGEN], 1u);
            else XB_SPIN(xb_ld(&bar[XB_TOPGEN]) == tg, bar);
            __builtin_amdgcn_fence(__ATOMIC_ACQUIRE, "agent");
            xb_add(&bar[XB_XGEN(b.x)], 1u);
            asm volatile("s_waitcnt vmcnt(0)" ::: "memory");
        } else {
            XB_SPIN(xb_ld(&bar[XB_XGEN(b.x)]) == gen, bar);
            __builtin_amdgcn_fence(__ATOMIC_ACQUIRE, "agent");
            asm volatile("s_waitcnt vmcnt(0)" ::: "memory");
        }
    }
    __syncthreads();
}

__device__ __forceinline__ bool tile_of(long L, int nM, int nN, int& pm, int& pn) {
  const int nwg = nM * nN; if (L >= nwg) return false;
  int wgid = (int)L; { const int q = nwg / 8, r = nwg % 8, xcd = wgid % 8, off = wgid / 8; wgid = (xcd < r ? xcd * (q + 1) : r * (q + 1) + (xcd - r) * q) + off; }
  const int nig = 8 * nN, gid = wgid / nig, fm = gid * 8, gsz = (nM - fm) < 8 ? (nM - fm) : 8;
  pm = fm + ((wgid % nig) % gsz); pn = (wgid % nig) / gsz; return true;
}
struct SchedGrid {
  const char* A; const char* B; size_t at, bt; int nM, nN, G, c;
  __device__ __forceinline__ bool next(int i, pg8::Unit& u) const { int pm, pn; if (!tile_of((long)i * G + c, nM, nN, pm, pn)) return false;
    u.pm = pm; u.pn = pn; u.a = A + (size_t)pm * at; u.b = B + (size_t)pn * bt; u.aux = 0; return true; }
  __device__ __forceinline__ void a_ready(const pg8::Unit&) const {}
  __device__ __forceinline__ void done(const pg8::Unit&) const {}
};
struct SchedUp {
  const char* A0; const char* B0; const char* A1; const char* B1; int G, c;
  __device__ __forceinline__ bool next(int i, pg8::Unit& u) const { const int L = i * G + c; if (L >= 256) return false;
    const int grp = L >> 7, t = L & 127; u.pm = t >> 1; u.pn = t & 1; u.aux = grp;
    u.a = (grp ? A1 : A0) + (size_t)u.pm * (256 * 256 * 2); u.b = (grp ? B1 : B0) + (size_t)u.pn * (256 * 256 * 2); return true; }
  __device__ __forceinline__ void a_ready(const pg8::Unit&) const {}
  __device__ __forceinline__ void done(const pg8::Unit&) const {}
};
struct SchedBranch {
  const char* Y; const char* W; int G, c;
  __device__ __forceinline__ bool next(int i, pg8::Unit& u) const { int pm, pn; if (!tile_of((long)(i >> 2) * G + c, 64, 4, pm, pn)) return false;
    const int n = i & 3; u.pm = pm; u.pn = pn; u.aux = n;
    u.a = Y + (size_t)pm * (256 * 1024 * 2) + n * 512; u.b = W + (size_t)n * (1024 * 256 * 2) + (size_t)pn * (256 * 256 * 2); return true; }
  __device__ __forceinline__ void a_ready(const pg8::Unit&) const {}
  __device__ __forceinline__ void done(const pg8::Unit&) const {}
};
struct SchedMoE {
  const char* A; const char* B; size_t at, bt, be; int nM, nN, G, c; int ps1, ps2, ps3, ps4, ps5, ps6, ps7;
  __device__ __forceinline__ bool next(int i, pg8::Unit& u) const { int pm, pn; if (!tile_of((long)i * G + c, nM, nN, pm, pn)) return false;
    const int r0 = pm * 256; const int e = (r0 >= ps1) + (r0 >= ps2) + (r0 >= ps3) + (r0 >= ps4) + (r0 >= ps5) + (r0 >= ps6) + (r0 >= ps7);
    u.pm = pm; u.pn = pn; u.aux = e; u.a = A + (size_t)pm * at; u.b = B + (size_t)e * be + (size_t)pn * bt; return true; }
  __device__ __forceinline__ void a_ready(const pg8::Unit&) const {}
  __device__ __forceinline__ void done(const pg8::Unit&) const {}
};

typedef const pg8::f32x4 (&AccRef)[2][2][4][2];
struct EpiProj { static constexpr bool PERM = true, AFTER_DRAIN = false; bf16_t* O;
  __device__ __forceinline__ void operator()(AccRef acc, const pg8::Unit& u, int wr, int wc, int fr, int fq) const {
    const int row0 = u.pm * 256 + wr * 64 + fr;
#pragma unroll
    for (int ai = 0; ai < 2; ++ai)
#pragma unroll
      for (int m = 0; m < 4; ++m) { bf16_t* rowp = O + (size_t)(row0 + ai * 128 + m * 16) * IN_COLS;
#pragma unroll
        for (int bj = 0; bj < 2; ++bj) { const int c0 = u.pn * 256 + bj * 128 + wc * 32 + 8 * fq;
          if (c0 < IN_COLS) { pg8::f32x4 v0 = acc[ai][bj][m][0], v1 = acc[ai][bj][m][1];
            if (c0 >= C_GATE) {
#pragma unroll
              for (int j = 0; j < 4; ++j) { v0[j] = fast_sigmoid(v0[j]); v1[j] = fast_sigmoid(v1[j]); } }
            u32x4 w; w.x = pg8::cvt_pk_bf16(v0[0], v0[1]); w.y = pg8::cvt_pk_bf16(v0[2], v0[3]); w.z = pg8::cvt_pk_bf16(v1[0], v1[1]); w.w = pg8::cvt_pk_bf16(v1[2], v1[3]);
            *(u32x4*)(rowp + c0) = w; } } }
  }
};
struct EpiUp { static constexpr bool PERM = false, AFTER_DRAIN = false; bf16_t* QM; bf16_t* KM; bf16_t* VM; const float* rope;
  __device__ __forceinline__ void operator()(AccRef acc, const pg8::Unit& u, int wr, int wc, int fr, int fq) const {
    const int row0 = u.pm * 256 + wr * 64 + fr;
    if (u.aux == 0) {
      const float sc = 0.10206207261596577f * 1.4426950408889634f;
#pragma unroll
      for (int bj = 0; bj < 2; ++bj) { const int g32 = (u.pn * 256 + bj * 128 + wc * 32) >> 5;
        if (g32 < 12) { const int h = g32 / 3, part = g32 - 3 * h;
#pragma unroll
          for (int ai = 0; ai < 2; ++ai)
#pragma unroll
            for (int m = 0; m < 4; ++m) { const int r = row0 + ai * 128 + m * 16; bf16_t* dst = QM + (size_t)r * 384 + h * 96 + part * 32 + 4 * fq;
              pg8::f32x4 v0 = acc[ai][bj][m][0], v1 = acc[ai][bj][m][1];
              if (part == 2) { const f32x4 cs = *(const f32x4*)(rope + (size_t)r * 32 + 4 * fq), sn = *(const f32x4*)(rope + (size_t)r * 32 + 16 + 4 * fq);
                const pg8::f32x4 a = v0, b = v1;
#pragma unroll
                for (int j = 0; j < 4; ++j) { v0[j] = a[j] * cs[j] - b[j] * sn[j]; v1[j] = a[j] * sn[j] + b[j] * cs[j]; } }
              u32x2 w0, w1; w0.x = pg8::cvt_pk_bf16(v0[0] * sc, v0[1] * sc); w0.y = pg8::cvt_pk_bf16(v0[2] * sc, v0[3] * sc);
              w1.x = pg8::cvt_pk_bf16(v1[0] * sc, v1[1] * sc); w1.y = pg8::cvt_pk_bf16(v1[2] * sc, v1[3] * sc);
              *(u32x2*)dst = w0; *(u32x2*)(dst + 16) = w1; } } }
    } else {
#pragma unroll
      for (int bj = 0; bj < 2; ++bj) { const int h = u.pn * 2 + bj;
#pragma unroll
        for (int ai = 0; ai < 2; ++ai)
#pragma unroll
          for (int m = 0; m < 4; ++m) { const int r = row0 + ai * 128 + m * 16;
#pragma unroll
            for (int n = 0; n < 2; ++n) { const int w = wc * 32 + 16 * n + 4 * fq; const pg8::f32x4 v = acc[ai][bj][m][n];
              u32x2 o; o.x = pg8::cvt_pk_bf16(v[0], v[1]); o.y = pg8::cvt_pk_bf16(v[2], v[3]);
              if (w < 64) *(u32x2*)(KM + (size_t)r * 384 + h * 96 + w) = o; else *(u32x2*)(VM + (size_t)r * 256 + h * 64 + (w - 64)) = o; } } }
    }
  }
};
struct EpiMerge { static constexpr bool PERM = true, AFTER_DRAIN = false; const bf16_t* PROJ; float* TMP; bf16_t* MB;
  __device__ __forceinline__ void operator()(AccRef acc, const pg8::Unit& u, int wr, int wc, int fr, int fq) const {
    const int row0 = u.pm * 256 + wr * 64 + fr, n = u.aux;
#pragma unroll
    for (int ai = 0; ai < 2; ++ai)
#pragma unroll
      for (int m = 0; m < 4; ++m) { const int r = row0 + ai * 128 + m * 16;
#pragma unroll
        for (int bj = 0; bj < 2; ++bj) { const int c0 = u.pn * 256 + bj * 128 + wc * 32 + 8 * fq;
          const u32x4 gw_ = *(const u32x4*)(PROJ + (size_t)r * IN_COLS + C_GATE + n * DM + c0);
          pg8::f32x4 v0 = acc[ai][bj][m][0], v1 = acc[ai][bj][m][1];
          v0[0] *= __uint_as_float(gw_.x << 16); v0[1] *= __uint_as_float(gw_.x & 0xffff0000u); v0[2] *= __uint_as_float(gw_.y << 16); v0[3] *= __uint_as_float(gw_.y & 0xffff0000u);
          v1[0] *= __uint_as_float(gw_.z << 16); v1[1] *= __uint_as_float(gw_.z & 0xffff0000u); v1[2] *= __uint_as_float(gw_.w << 16); v1[3] *= __uint_as_float(gw_.w & 0xffff0000u);
          float* tp = TMP + (size_t)r * DM + c0;
          if (n > 0) { v0 += *(const pg8::f32x4*)tp; v1 += *(const pg8::f32x4*)(tp + 4); }
          if (n < 3) { *(pg8::f32x4*)tp = v0; *(pg8::f32x4*)(tp + 4) = v1; }
          else { u32x4 w; w.x = pg8::cvt_pk_bf16(v0[0], v0[1]); w.y = pg8::cvt_pk_bf16(v0[2], v0[3]); w.z = pg8::cvt_pk_bf16(v1[0], v1[1]); w.w = pg8::cvt_pk_bf16(v1[2], v1[3]);
            *(u32x4*)(MB + (size_t)r * DM + c0) = w; }
          asm volatile("" ::: "memory"); } }
  }
};
struct EpiRes { static constexpr bool PERM = false, AFTER_DRAIN = false; const float* res; float* T;
  __device__ __forceinline__ void operator()(AccRef acc, const pg8::Unit& u, int wr, int wc, int fr, int fq) const {
    const int row0 = u.pm * 256 + wr * 64 + fr, col0 = u.pn * 256 + wc * 32 + 4 * fq;
#pragma unroll
    for (int ai = 0; ai < 2; ++ai)
#pragma unroll
      for (int m = 0; m < 4; ++m) { const size_t off = (size_t)(row0 + ai * 128 + m * 16) * DM + col0;
#pragma unroll
        for (int bj = 0; bj < 2; ++bj)
#pragma unroll
          for (int n = 0; n < 2; ++n) { const pg8::f32x4 rv = *(const pg8::f32x4*)(res + off + bj * 128 + n * 16);
            *(pg8::f32x4*)(T + off + bj * 128 + n * 16) = rv * ALPHA + acc[ai][bj][m][n]; } }
  }
};
struct EpiBf { static constexpr bool PERM = true, AFTER_DRAIN = false; bf16_t* O; int ldc; float sc;
  __device__ __forceinline__ void operator()(AccRef acc, const pg8::Unit& u, int wr, int wc, int fr, int fq) const {
    const int row0 = u.pm * 256 + wr * 64 + fr;
#pragma unroll
    for (int ai = 0; ai < 2; ++ai)
#pragma unroll
      for (int m = 0; m < 4; ++m) { bf16_t* rowp = O + (size_t)(row0 + ai * 128 + m * 16) * ldc + u.pn * 256 + wc * 32 + 8 * fq;
#pragma unroll
        for (int bj = 0; bj < 2; ++bj) { const pg8::f32x4 v0 = acc[ai][bj][m][0] * sc, v1 = acc[ai][bj][m][1] * sc;
          u32x4 w; w.x = pg8::cvt_pk_bf16(v0[0], v0[1]); w.y = pg8::cvt_pk_bf16(v0[2], v0[3]); w.z = pg8::cvt_pk_bf16(v1[0], v1[1]); w.w = pg8::cvt_pk_bf16(v1[2], v1[3]);
          *(u32x4*)(rowp + bj * 128) = w; } }
  }
};
struct EpiSwiGLU { static constexpr bool PERM = true, AFTER_DRAIN = false; bf16_t* H; int ldh;
  __device__ __forceinline__ void operator()(AccRef acc, const pg8::Unit& u, int wr, int wc, int fr, int fq) const {
    const int row0 = u.pm * 256 + wr * 64 + fr;
#pragma unroll
    for (int ai = 0; ai < 2; ++ai)
#pragma unroll
      for (int m = 0; m < 4; ++m) { bf16_t* dst = H + (size_t)(row0 + ai * 128 + m * 16) * ldh + u.pn * 128 + wc * 32 + 8 * fq;
        float h[8];
#pragma unroll
        for (int n = 0; n < 2; ++n)
#pragma unroll
          for (int j = 0; j < 4; ++j) { const float a = acc[ai][0][m][n][j], g = acc[ai][1][m][n][j]; h[n * 4 + j] = a * fast_sigmoid(a) * g; }
        u32x4 w; w.x = pg8::cvt_pk_bf16(h[0], h[1]); w.y = pg8::cvt_pk_bf16(h[2], h[3]); w.z = pg8::cvt_pk_bf16(h[4], h[5]); w.w = pg8::cvt_pk_bf16(h[6], h[7]);
        *(u32x4*)dst = w; }
  }
};
struct EpiF32 { static constexpr bool PERM = false, AFTER_DRAIN = false; float* O;
  __device__ __forceinline__ void operator()(AccRef acc, const pg8::Unit& u, int wr, int wc, int fr, int fq) const {
    const int row0 = u.pm * 256 + wr * 64 + fr, col0 = u.pn * 256 + wc * 32 + 4 * fq;
#pragma unroll
    for (int ai = 0; ai < 2; ++ai)
#pragma unroll
      for (int m = 0; m < 4; ++m) { const size_t off = (size_t)(row0 + ai * 128 + m * 16) * DM + col0;
#pragma unroll
        for (int bj = 0; bj < 2; ++bj)
#pragma unroll
          for (int n = 0; n < 2; ++n) *(pg8::f32x4*)(O + off + bj * 128 + n * 16) = acc[ai][bj][m][n]; }
  }
};


typedef short bf16x8_t __attribute__((ext_vector_type(8)));
typedef short s16x4_t __attribute__((ext_vector_type(4)));
typedef float f32x16 __attribute__((ext_vector_type(16)));
__device__ __forceinline__ int crow(int r, int hi) { return (r & 3) + 8 * (r >> 2) + 4 * hi; }
__device__ __forceinline__ s16x4_t vtr(const LAS unsigned char* p) { return __builtin_bit_cast(s16x4_t, __builtin_amdgcn_ds_read_tr16_b64_v4i16((LAS s16x4_t*)p)); }
__device__ __forceinline__ unsigned cvtpk(float lo, float hi) { unsigned r; asm volatile("v_cvt_pk_bf16_f32 %0, %1, %2" : "=v"(r) : "v"(lo), "v"(hi)); return r; }
__device__ __forceinline__ float fmax3(float a, float b, float c) { return fmaxf(fmaxf(a, b), c); }

constexpr int MLA_KS = 208, MLA_VS = 192, MLA_KB = 64 * MLA_KS, MLA_VB = 64 * MLA_VS, MLA_COMB = 65536;
__device__ __forceinline__ void mla_unit(LAS unsigned char* lds, const bf16_t* __restrict__ QMp, const bf16_t* __restrict__ KMp, const bf16_t* __restrict__ VMp, bf16_t* __restrict__ Yp,
                                         int b, int h, int qb, int tid) {
  const int lane = tid & 63, wave = __builtin_amdgcn_readfirstlane(tid >> 6), r32 = lane & 31, hi = lane >> 5, g = wave >> 2, wq = wave & 3;
  const int q0 = qb * 128, NTL = 2 * qb + 2;
  const size_t rowbase = (size_t)b * SEQ;
  const int qrow = q0 + 32 * wq + r32;
  bf16x8_t qf[6];
  { const bf16_t* qp = QMp + ((rowbase + qrow) * 4 + h) * 96 + 8 * hi;
#pragma unroll
    for (int s = 0; s < 6; ++s) qf[s] = *(const bf16x8_t*)(qp + 16 * s); }
  f32x16 o0, o1;
#pragma unroll
  for (int i = 0; i < 16; ++i) { o0[i] = 0.f; o1[i] = 0.f; }
  float m = -1e30f, l = 0.f;
  const int kr0 = tid / 12, kc0 = tid % 12, kr1 = (tid + 512) / 12, kc1 = (tid + 512) % 12, vr = tid >> 3, vc = tid & 7;
  const unsigned char* kg0 = (const unsigned char*)KMp + ((rowbase + kr0) * 4 + h) * 192 + kc0 * 16;
  const unsigned char* kg1 = (const unsigned char*)KMp + ((rowbase + kr1) * 4 + h) * 192 + kc1 * 16;
  const unsigned char* vg = (const unsigned char*)VMp + ((rowbase + vr) * 4 + h) * 128 + vc * 16;
  const int kl0 = kr0 * MLA_KS + kc0 * 16, kl1 = kr1 * MLA_KS + kc1 * 16, vl = vr * MLA_VS + vc * 16;
  u32x4 ka, kb_, va;
  ka = *(const u32x4*)kg0; if (tid < 256) kb_ = *(const u32x4*)kg1; va = *(const u32x4*)vg;
  *(LAS u32x4*)(lds + kl0) = ka; if (tid < 256) *(LAS u32x4*)(lds + kl1) = kb_; *(LAS u32x4*)(lds + 2 * MLA_KB + vl) = va;
  __syncthreads();
  const int gi = lane & 15, g16 = lane >> 4;
  const int koff = (32 * g + r32) * MLA_KS + hi * 16;
  const int voff = (32 * g + 4 * hi + (gi >> 2)) * MLA_VS + (16 * (g16 & 1) + 4 * (gi & 3)) * 2;
  const int qmin = q0 + 32 * wq;
  for (int kt = 0; kt < NTL; ++kt) {
    const int cur = kt & 1;
    if (kt + 1 < NTL) { const size_t ko = (size_t)(kt + 1) * (64 * 768), vo = (size_t)(kt + 1) * (64 * 512);
      ka = *(const u32x4*)(kg0 + ko); if (tid < 256) kb_ = *(const u32x4*)(kg1 + ko); va = *(const u32x4*)(vg + vo); }
    const int kvb = 64 * kt + 32 * g;
    if (kvb <= qmin + 31) {
      const LAS unsigned char* kbp = lds + cur * MLA_KB + koff;
      f32x16 p;
#pragma unroll
      for (int i = 0; i < 16; ++i) p[i] = 0.f;
#pragma unroll
      for (int s = 0; s < 6; ++s) { const bf16x8_t kf = *(const LAS bf16x8_t*)(kbp + 32 * s); p = __builtin_amdgcn_mfma_f32_32x32x16_bf16(kf, qf[s], p, 0, 0, 0); }
      if (kvb + 31 > qmin) {
#pragma unroll
        for (int i = 0; i < 16; ++i) if (kvb + crow(i, hi) > qrow) p[i] = -INFINITY;
      }
      float tm = fmax3(p[0], p[1], p[2]);
#pragma unroll
      for (int i = 3; i < 15; i += 2) tm = fmax3(tm, p[i], p[i + 1]);
      tm = fmaxf(tm, p[15]);
      tm = fmaxf(tm, __shfl_xor(tm, 32));
      if (!__all(tm <= m)) { const float mn = fmaxf(m, tm), al = __builtin_amdgcn_exp2f(m - mn); l *= al; m = mn;
#pragma unroll
        for (int i = 0; i < 16; ++i) { o0[i] *= al; o1[i] *= al; } }
      float ls = 0.f;
#pragma unroll
      for (int i = 0; i < 16; ++i) { p[i] = __builtin_amdgcn_exp2f(p[i] - m); ls += p[i]; }
      l += ls;
      u32x4 pw0, pw1;
      pw0.x = cvtpk(p[0], p[1]); pw0.y = cvtpk(p[2], p[3]); pw0.z = cvtpk(p[4], p[5]); pw0.w = cvtpk(p[6], p[7]);
      pw1.x = cvtpk(p[8], p[9]); pw1.y = cvtpk(p[10], p[11]); pw1.z = cvtpk(p[12], p[13]); pw1.w = cvtpk(p[14], p[15]);
      const bf16x8_t pf0 = __builtin_bit_cast(bf16x8_t, pw0), pf1 = __builtin_bit_cast(bf16x8_t, pw1);
      const LAS unsigned char* vbp = lds + 2 * MLA_KB + cur * MLA_VB + voff;
#pragma unroll
      for (int s = 0; s < 2; ++s) {
        const s16x4_t a0 = vtr(vbp + (16 * s) * MLA_VS), a1 = vtr(vbp + (16 * s + 8) * MLA_VS);
        const s16x4_t c0 = vtr(vbp + (16 * s) * MLA_VS + 64), c1 = vtr(vbp + (16 * s + 8) * MLA_VS + 64);
        const bf16x8_t vf0 = (bf16x8_t){a0[0], a0[1], a0[2], a0[3], a1[0], a1[1], a1[2], a1[3]};
        const bf16x8_t vf1 = (bf16x8_t){c0[0], c0[1], c0[2], c0[3], c1[0], c1[1], c1[2], c1[3]};
        o0 = __builtin_amdgcn_mfma_f32_32x32x16_bf16(vf0, s ? pf1 : pf0, o0, 0, 0, 0);
        o1 = __builtin_amdgcn_mfma_f32_32x32x16_bf16(vf1, s ? pf1 : pf0, o1, 0, 0, 0);
      }
    }
    if (kt + 1 < NTL) { const int nb = cur ^ 1;
      *(LAS u32x4*)(lds + nb * MLA_KB + kl0) = ka; if (tid < 256) *(LAS u32x4*)(lds + nb * MLA_KB + kl1) = kb_; *(LAS u32x4*)(lds + 2 * MLA_KB + nb * MLA_VB + vl) = va; }
    __syncthreads();
  }
  l += __shfl_xor(l, 32);
  LAS float* cb = (LAS float*)(lds + MLA_COMB) + wq * (34 * 64) + lane;
  if (g == 1) { cb[0] = m; cb[64] = l;
#pragma unroll
    for (int i = 0; i < 16; ++i) { cb[(2 + i) * 64] = o0[i]; cb[(18 + i) * 64] = o1[i]; } }
  __syncthreads();
  if (g == 0) { const float m1 = cb[0], l1 = cb[64]; const float mt = fmaxf(m, m1), a0 = __builtin_amdgcn_exp2f(m - mt), a1 = __builtin_amdgcn_exp2f(m1 - mt);
    const float inv = 1.0f / (l * a0 + l1 * a1);
    bf16_t* yp = Yp + (rowbase + qrow) * DM + h * 64 + 4 * hi;
#pragma unroll
    for (int q4 = 0; q4 < 4; ++q4) { float v0[4], v1[4];
#pragma unroll
      for (int j = 0; j < 4; ++j) { const int i = q4 * 4 + j; v0[j] = (o0[i] * a0 + cb[(2 + i) * 64] * a1) * inv; v1[j] = (o1[i] * a0 + cb[(18 + i) * 64] * a1) * inv; }
      u32x2 w0, w1; w0.x = cvtpk(v0[0], v0[1]); w0.y = cvtpk(v0[2], v0[3]); w1.x = cvtpk(v1[0], v1[1]); w1.y = cvtpk(v1[2], v1[3]);
      *(u32x2*)(yp + 8 * q4) = w0; *(u32x2*)(yp + 32 + 8 * q4) = w1; } }
  __syncthreads();
}


__device__ __forceinline__ float hgrn_forget(float fraw, float lb) { return lb + (1.f - lb) * (1.f / (1.f + __expf(-fraw))); }
__device__ __forceinline__ void hgrn_stepA(float* sm, const bf16_t* __restrict__ PROJp, const float* __restrict__ lbl, int l, float* __restrict__ HGH, float* __restrict__ HGD, float* __restrict__ HGB,
                                           int ci, int tid) {
  const int lane = tid & 63, wave = tid >> 6;
  float* sKF = sm; float* sBC = sm + 4096; float* sV = sm + 8192; float* sBL = sm + 12288;
  const int bh = ci >> 7, c = ci & 127, b = bh >> 2, h = bh & 3; const size_t row0 = (size_t)b * SEQ + c * 64;
  const int k = tid & 63;
  float lb = 0.f; if (l == 1) { const float l0 = lbl[h * 64 + k], l1 = lbl[256 + h * 64 + k]; lb = 1.f / (1.f + expf(l0 - l1)); }
#pragma unroll
  for (int j = 0; j < 8; ++j) { const int e = tid + 512 * j, s = e >> 6; const bf16_t* pr = PROJp + (row0 + s) * IN_COLS;
    const float fg = hgrn_forget(bf2f(pr[C_HF + h * 64 + k]), lb); sBC[e] = logf(fg); sKF[e] = 1.f - fg; sV[e] = bf2f(pr[C_HI + h * 64 + k]); }
  __syncthreads();
  if (wave == 0) { float run = 0.f;
    for (int s = 0; s < 64; ++s) { run += sBC[s * 64 + lane]; sBC[s * 64 + lane] = run; }
    sBL[lane] = run; HGD[(size_t)ci * 64 + lane] = expf(run); }
  __syncthreads();
  { const float bl = sBL[k];
#pragma unroll
    for (int j = 0; j < 8; ++j) { const int e = tid + 512 * j; const float bc = sBC[e]; HGB[(size_t)ci * 4096 + e] = bc; sKF[e] = sKF[e] * expf(bl - bc); } }
  __syncthreads();
  float acc[8];
#pragma unroll
  for (int i = 0; i < 8; ++i) acc[i] = 0.f;
  for (int s = 0; s < 64; ++s) { const float vv = sV[s * 64 + lane]; const f32x4 k0 = *(const f32x4*)&sKF[s * 64 + wave * 8], k1 = *(const f32x4*)&sKF[s * 64 + wave * 8 + 4];
    acc[0] += k0[0] * vv; acc[1] += k0[1] * vv; acc[2] += k0[2] * vv; acc[3] += k0[3] * vv; acc[4] += k1[0] * vv; acc[5] += k1[1] * vv; acc[6] += k1[2] * vv; acc[7] += k1[3] * vv; }
#pragma unroll
  for (int i = 0; i < 8; ++i) HGH[(size_t)ci * 4096 + (wave * 8 + i) * 64 + lane] = acc[i];
  __syncthreads();
}
__device__ __forceinline__ void hgrn_stepB(float* sm, const float* __restrict__ HGH, const float* __restrict__ HGD, float* __restrict__ HGS, int pairblk, int tid) {
  const int lane = tid & 63, wave = tid >> 6, seg = wave & 3;
  const int rowid = pairblk * 2 + (wave >> 2), bh = rowid >> 6, k = rowid & 63;
  const size_t cbase = (size_t)bh * 128 + seg * 32;
  float P = 1.f, Q = 0.f;
  for (int c = 0; c < 32; ++c) { const float d = HGD[(cbase + c) * 64 + k], hh = HGH[(cbase + c) * 4096 + k * 64 + lane]; Q = d * Q + hh; P *= d; }
  float* sP = sm + (wave >> 2) * 4; float* sQ = sm + 16 + (wave >> 2) * 256;
  sQ[seg * 64 + lane] = Q; if (lane == 0) sP[seg] = P;
  __syncthreads();
  float S = 0.f;
  for (int s2 = 0; s2 < seg; ++s2) S = sP[s2] * S + sQ[s2 * 64 + lane];
  for (int c = 0; c < 32; ++c) { const float d = HGD[(cbase + c) * 64 + k], hh = HGH[(cbase + c) * 4096 + k * 64 + lane];
    HGS[(cbase + c) * 4096 + k * 64 + lane] = S; S = d * S + hh; }
  __syncthreads();
}
__device__ __forceinline__ void hgrn_stepC(float* sm, const bf16_t* __restrict__ PROJp, const float* __restrict__ lbl, const float* __restrict__ hnorm, int l,
                                           const float* __restrict__ HGB, const float* __restrict__ HGS, bf16_t* __restrict__ Yp, int ci, int tid) {
  const int lane = tid & 63, wave = tid >> 6;
  float* sQ = sm; float* sBC = sm + 4096; float* sV = sm + 8192; float* sS = sm + 12288; float* sATT = sm + 16384; float* sKFT = sm + 20480; float* sBCT = sm + 20480 + 4160;
  const int bh = ci >> 7, c = ci & 127, b = bh >> 2, h = bh & 3; const size_t row0 = (size_t)b * SEQ + c * 64;
  const int k = tid & 63;
  float lb = 0.f; if (l == 1) { const float l0 = lbl[h * 64 + k], l1 = lbl[256 + h * 64 + k]; lb = 1.f / (1.f + expf(l0 - l1)); }
#pragma unroll
  for (int j = 0; j < 8; ++j) { const int e = tid + 512 * j, t = e >> 6; const bf16_t* pr = PROJp + (row0 + t) * IN_COLS;
    const float qv = bf2f(pr[C_HQ + h * 64 + k]); sQ[e] = qv / (1.f + __expf(-qv));
    const float bc = HGB[(size_t)ci * 4096 + e]; sBC[e] = bc; sBCT[k * 65 + t] = bc;
    sKFT[k * 65 + t] = 1.f - hgrn_forget(bf2f(pr[C_HF + h * 64 + k]), lb);
    sV[e] = bf2f(pr[C_HI + h * 64 + k]); sS[e] = HGS[(size_t)ci * 4096 + e]; }
  __syncthreads();
#pragma unroll 1
  for (int i = 0; i < 8; ++i) { const int t = wave * 8 + i; float a = 0.f;
    if (lane <= t) {
#pragma unroll 2
      for (int kk = 0; kk < 64; kk += 4) { const f32x4 q4 = *(const f32x4*)&sQ[t * 64 + kk], b4 = *(const f32x4*)&sBC[t * 64 + kk];
#pragma unroll
        for (int u = 0; u < 4; ++u) a += q4[u] * sKFT[(kk + u) * 65 + lane] * __expf(b4[u] - sBCT[(kk + u) * 65 + lane]); } }
    sATT[t * 64 + lane] = a; }
  __syncthreads();
  const float nw = hnorm[l * 256 + h * 64 + lane];
#pragma unroll 1
  for (int i = 0; i < 8; ++i) { const int t = wave * 8 + i; float o = 0.f;
#pragma unroll 2
    for (int kk = 0; kk < 64; kk += 4) { const f32x4 q4 = *(const f32x4*)&sQ[t * 64 + kk], b4 = *(const f32x4*)&sBC[t * 64 + kk];
#pragma unroll
      for (int u = 0; u < 4; ++u) o += (q4[u] * __expf(b4[u])) * sS[(kk + u) * 64 + lane]; }
#pragma unroll 4
    for (int s = 0; s <= t; ++s) o += sATT[t * 64 + s] * sV[s * 64 + lane];
    const float ms = wave_sum(o * o) * (1.f / 64.f);
    const float gv = bf2f(PROJp[(row0 + t) * IN_COLS + C_HG + h * 64 + lane]);
    Yp[(row0 + t) * DM + 512 + h * 64 + lane] = f2bf(o * rsqrtf(ms + EPS) * nw * (gv / (1.f + __expf(-gv)))); }
  __syncthreads();
}

__device__ __forceinline__ void tr_item(const float* W, int ldw, int k0, int n0, bf16_t* dst, int dst_ld, int drow0, LAS float* scr, int lane) {
#pragma unroll 8
  for (int i = 0; i < 32; ++i) { const int kk = 2 * i + (lane >> 5); scr[kk * 33 + (lane & 31)] = W[(size_t)(k0 + kk) * ldw + n0 + (lane & 31)]; }
  asm volatile("s_waitcnt lgkmcnt(0)" ::: "memory");
  const int c = lane & 7;
#pragma unroll
  for (int j = 0; j < 4; ++j) { const int n = (lane >> 3) + 8 * j; const LAS float* s = scr + (8 * c) * 33 + n;
    u32x4 o; o.x = pk2(s[0 * 33], s[1 * 33]); o.y = pk2(s[2 * 33], s[3 * 33]); o.z = pk2(s[4 * 33], s[5 * 33]); o.w = pk2(s[6 * 33], s[7 * 33]);
    *(u32x4*)(dst + (size_t)(drow0 + n) * dst_ld + k0 + 8 * c) = o; }
  asm volatile("s_waitcnt lgkmcnt(0)" ::: "memory");
}
__device__ __forceinline__ int pair_row(int c, int F) { const int g = c >= F ? 1 : 0, cc = c - g * F; return (cc >> 7) * 256 + g * 128 + (cc & 127); }

__device__ __forceinline__ void ln_rows(const float* T, float* dst, bf16_t* dstb, const float* g, const float* b, int gw, int ngw, int lane) {
  for (int r = gw; r < M; r += ngw) {
    const f32x4* tr = (const f32x4*)(T + (size_t)r * DM) + lane;
    f32x4 v[4]; float s = 0.f;
#pragma unroll
    for (int j = 0; j < 4; ++j) { v[j] = tr[64 * j]; s += (v[j][0] + v[j][1]) + (v[j][2] + v[j][3]); }
    const float mean = wave_sum(s) * (1.f / DM); float s2 = 0.f;
#pragma unroll
    for (int j = 0; j < 4; ++j) { v[j] = v[j] - mean; s2 += (v[j][0] * v[j][0] + v[j][1] * v[j][1]) + (v[j][2] * v[j][2] + v[j][3] * v[j][3]); }
    const float rstd = rsqrtf(wave_sum(s2) * (1.f / DM) + EPS);
    f32x4* o = (f32x4*)(dst + (size_t)r * DM) + lane; u32x2* ob = (u32x2*)(dstb + (size_t)r * DM) + lane;
#pragma unroll
    for (int j = 0; j < 4; ++j) { const f32x4 gg = ((const f32x4*)g)[lane + 64 * j], bb = ((const f32x4*)b)[lane + 64 * j]; const f32x4 y = v[j] * rstd * gg + bb; o[64 * j] = y;
      u32x2 w; w.x = pk2(y[0], y[1]); w.y = pk2(y[2], y[3]); ob[64 * j] = w; }
  }
}


__device__ __forceinline__ unsigned char* launder_p(unsigned char* q) { asm volatile("" : "+s"(q)); return q; }
#define ctl ((unsigned*)(ws + WS_CTL))
#define X ((float*)(ws + WS_X))
#define T ((float*)(ws + WS_T))
#define XB ((bf16_t*)(ws + WS_XB))
#define Y ((bf16_t*)(ws + WS_Y))
#define MB ((bf16_t*)(ws + WS_MB))
#define QM ((bf16_t*)(ws + WS_QM))
#define KM ((bf16_t*)(ws + WS_KM))
#define VM ((bf16_t*)(ws + WS_VM))
#define CQN ((bf16_t*)(ws + WS_CQN))
#define CKVN ((bf16_t*)(ws + WS_CKVN))
#define XQ ((bf16_t*)(ws + WS_XQ))
#define XO ((bf16_t*)(ws + WS_XO))
#define ROPE ((float*)(ws + WS_ROPE))
#define KVMEM ((float*)(ws + WS_KVMEM))
#define PROJ ((bf16_t*)(ws + WS_BIG))
#define H2 ((bf16_t*)(ws + WS_BIG))
#define YS ((float*)(ws + WS_YS))
#define XG ((bf16_t*)(ws + WS_XG))
#define tok_e ((int*)(ws + WS_ROUTE))
#define tok_p (tok_e + 2 * M)
#define tok_w ((float*)(tok_p + 2 * M))
#define tok_slot ((int*)(tok_w + 2 * M))
#define GEMM_PHASE(EpiT, SchedT, g, S, E) pg8::gemm_phase<EpiT, SchedT, true, true>(lds3, g, S, E, tid)
__global__ void __launch_bounds__(NT) mega(Params p) {
  extern __shared__ __attribute__((aligned(16))) unsigned char lds_raw[];
  float* sm = (float*)lds_raw;
  LAS unsigned char* lds30 = (LAS unsigned char*)lds_raw;
  const int G0 = gridDim.x, bid0 = blockIdx.x, wave0 = __builtin_amdgcn_readfirstlane((int)threadIdx.x >> 6);
  { LAS unsigned long long* PTAB = (LAS unsigned long long*)(lds30 + 131072 + 1024);
  if (threadIdx.x == 0) {
    PTAB[0] = (unsigned long long)(uintptr_t)p.x;
    PTAB[1] = (unsigned long long)(uintptr_t)p.mem;
    PTAB[2] = (unsigned long long)(uintptr_t)p.pos;
    PTAB[3] = (unsigned long long)(uintptr_t)p.rel;
    PTAB[4] = (unsigned long long)(uintptr_t)p.lbl;
    PTAB[5] = (unsigned long long)(uintptr_t)p.w_in;
    PTAB[6] = (unsigned long long)(uintptr_t)p.qnorm;
    PTAB[7] = (unsigned long long)(uintptr_t)p.w_uq;
    PTAB[8] = (unsigned long long)(uintptr_t)p.kvnorm;
    PTAB[9] = (unsigned long long)(uintptr_t)p.w_ukv;
    PTAB[10] = (unsigned long long)(uintptr_t)p.sinks;
    PTAB[11] = (unsigned long long)(uintptr_t)p.hnorm;
    PTAB[12] = (unsigned long long)(uintptr_t)p.w_branch;
    PTAB[13] = (unsigned long long)(uintptr_t)p.w_out;
    PTAB[14] = (unsigned long long)(uintptr_t)p.ln_g;
    PTAB[15] = (unsigned long long)(uintptr_t)p.ln_b;
    PTAB[16] = (unsigned long long)(uintptr_t)p.xa_wq;
    PTAB[17] = (unsigned long long)(uintptr_t)p.xa_wkv;
    PTAB[18] = (unsigned long long)(uintptr_t)p.xa_wo;
    PTAB[19] = (unsigned long long)(uintptr_t)p.ffn_w13;
    PTAB[20] = (unsigned long long)(uintptr_t)p.ffn_w2;
    PTAB[21] = (unsigned long long)(uintptr_t)p.router;
    PTAB[22] = (unsigned long long)(uintptr_t)p.moe_w13;
    PTAB[23] = (unsigned long long)(uintptr_t)p.moe_w2;
    PTAB[24] = (unsigned long long)(uintptr_t)p.out;
    PTAB[25] = (unsigned long long)(uintptr_t)p.ws;
  } }
  volatile LAS unsigned* MISC = (volatile LAS unsigned*)(lds30 + 131072 + 320);
  if (threadIdx.x < 32) MISC[threadIdx.x] = 0u;
  __syncthreads();
  const XcdBarrier xbar = xcd_barrier_post((unsigned*)(p.ws + WS_CTL) + CW_BAR, MISC + 8);
#define GRID_SYNC() do { PHASE_IDS xcd_barrier(xbar, tid); } while (0)
  { PHASE_IDS
    LAS float* scr = (LAS float*)(lds3 + wave * 16384);
    constexpr int I_IN = 16 * 213, I_UQ = 4 * 12, I_UKV = 2 * 16, I_BR = 4 * 32, I_OUT = 16 * 32, I_XQ = 16 * 8, I_XO = 4 * 32, I_F13 = 16 * 176, I_F2 = 44 * 32, I_M13 = 16 * 224, I_M2 = 56 * 32;
    constexpr int N_ITEMS = 2 * I_IN + 2 * I_UQ + 2 * I_UKV + 8 * I_BR + 2 * I_OUT + 2 * I_XQ + 2 * I_XO + I_F13 + I_F2 + 8 * I_M13 + 8 * I_M2;
    for (int it = gw; it < N_ITEMS; it += ngw) {
      int r = it;
      if (r < 2 * I_IN) { const int l = r / I_IN, q = r % I_IN, kb = q / 213, nb = q % 213;
        tr_item(((const float*)ptab_get(PTAB, 5)) + (size_t)l * DM * IN_COLS, IN_COLS, kb * 64, nb * 32, (bf16_t*)(ws + W_IN) + (size_t)l * IN_PAD * 1024, 1024, nb * 32, scr, lane); continue; } r -= 2 * I_IN;
      if (r < 2 * I_UQ) { const int l = r / I_UQ, q = r % I_UQ, kb = q / 12, nb = q % 12;
        tr_item(((const float*)ptab_get(PTAB, 7)) + (size_t)l * 256 * 384, 384, kb * 64, nb * 32, (bf16_t*)(ws + W_UQ) + (size_t)l * 512 * 256, 256, nb * 32, scr, lane); continue; } r -= 2 * I_UQ;
      if (r < 2 * I_UKV) { const int l = r / I_UKV, q = r % I_UKV, kb = q / 16, nb = q % 16;
        tr_item(((const float*)ptab_get(PTAB, 9)) + (size_t)l * 128 * 512, 512, kb * 64, nb * 32, (bf16_t*)(ws + W_UKV) + (size_t)l * 512 * 256, 256, nb * 32, scr, lane); continue; } r -= 2 * I_UKV;
      if (r < 8 * I_BR) { const int ln = r / I_BR, q = r % I_BR, kb = q / 32, nb = q % 32;
        tr_item(((const float*)ptab_get(PTAB, 12)) + (size_t)ln * 256 * 1024, 1024, kb * 64, nb * 32, (bf16_t*)(ws + W_BR) + (size_t)ln * 1024 * 256, 256, nb * 32, scr, lane); continue; } r -= 8 * I_BR;
      if (r < 2 * I_OUT) { const int l = r / I_OUT, q = r % I_OUT, kb = q / 32, nb = q % 32;
        tr_item(((const float*)ptab_get(PTAB, 13)) + (size_t)l * 1024 * 1024, 1024, kb * 64, nb * 32, (bf16_t*)(ws + W_OUT) + (size_t)l * 1024 * 1024, 1024, nb * 32, scr, lane); continue; } r -= 2 * I_OUT;
      if (r < 2 * I_XQ) { const int l = r / I_XQ, q = r % I_XQ, kb = q / 8, nb = q % 8;
        tr_item(((const float*)ptab_get(PTAB, 16)) + (size_t)l * 1024 * 256, 256, kb * 64, nb * 32, (bf16_t*)(ws + W_XQ) + (size_t)l * 256 * 1024, 1024, nb * 32, scr, lane); continue; } r -= 2 * I_XQ;
      if (r < 2 * I_XO) { const int l = r / I_XO, q = r % I_XO, kb = q / 32, nb = q % 32;
        tr_item(((const float*)ptab_get(PTAB, 18)) + (size_t)l * 256 * 1024, 1024, kb * 64, nb * 32, (bf16_t*)(ws + W_XO) + (size_t)l * 1024 * 256, 256, nb * 32, scr, lane); continue; } r -= 2 * I_XO;
      if (r < I_F13) { const int kb = r / 176, nb = r % 176;
        tr_item(((const float*)ptab_get(PTAB, 19)), 2 * F_DENSE, kb * 64, nb * 32, (bf16_t*)(ws + W_F13), 1024, pair_row(nb * 32, F_DENSE), scr, lane); continue; } r -= I_F13;
      if (r < I_F2) { const int kb = r / 32, nb = r % 32;
        tr_item(((const float*)ptab_get(PTAB, 20)), 1024, kb * 64, nb * 32, (bf16_t*)(ws + W_F2), F_DENSE, nb * 32, scr, lane); continue; } r -= I_F2;
      if (r < 8 * I_M13) { const int e = r / I_M13, q = r % I_M13, kb = q / 224, nb = q % 224;
        tr_item(((const float*)ptab_get(PTAB, 22)) + (size_t)e * 1024 * 2 * F_EXP, 2 * F_EXP, kb * 64, nb * 32, (bf16_t*)(ws + W_M13) + (size_t)e * 2 * F_EXP * 1024, 1024, pair_row(nb * 32, F_EXP), scr, lane); continue; } r -= 8 * I_M13;
      { const int e = r / I_M2, q = r % I_M2, kb = q / 32, nb = q % 32;
        tr_item(((const float*)ptab_get(PTAB, 23)) + (size_t)e * F_EXP * 1024, 1024, kb * 64, nb * 32, (bf16_t*)(ws + W_M2) + (size_t)e * 1024 * F_EXP, F_EXP, nb * 32, scr, lane); }
    }
    const int gt = bid * NT + tid, ngt = G * NT;
    for (int i = gt; i < 2 * 96 * 1024 / 8; i += ngt) { const int l = i / (96 * 128), q = i % (96 * 128); ((u32x4*)((bf16_t*)(ws + W_IN) + ((size_t)l * IN_PAD + IN_COLS) * 1024))[q] = (u32x4){0u, 0u, 0u, 0u}; }
    for (int i = gt; i < 2 * 128 * 256 / 8; i += ngt) { const int l = i / (128 * 32), q = i % (128 * 32); ((u32x4*)((bf16_t*)(ws + W_UQ) + ((size_t)l * 512 + 384) * 256))[q] = (u32x4){0u, 0u, 0u, 0u}; }
    for (int i = gt; i < 2 * 512 * 16; i += ngt) { const int row = i / 16, q = i % 16; ((u32x4*)((bf16_t*)(ws + W_UKV) + (size_t)row * 256 + 128))[q] = (u32x4){0u, 0u, 0u, 0u}; }
    for (int i = gt; i < M * DM / 4; i += ngt) { const f32x4 v = ((const f32x4*)((const float*)ptab_get(PTAB, 0)))[i]; u32x2 w; w.x = pk2(v[0], v[1]); w.y = pk2(v[2], v[3]); ((u32x2*)XB)[i] = w; }
  }
  cg::this_grid().sync();

  for (int l = 0; l < DEPTH; ++l) {
    { PHASE_IDS
      if (bid >= G - 16) {
        float acc[4][8], acc2[4][8];
        const float* Wkv = ((const float*)ptab_get(PTAB, 17)) + (size_t)l * DM * 512;
        const int t = bid - (G - 16), tm = t / 4, tn = t % 4;
        tile_mm<float, false>(acc, acc2, ((const float*)ptab_get(PTAB, 1)), DM, nullptr, tm * 128, Wkv, nullptr, 512, tn * 128, 512, DM, sm, tid);
#pragma unroll
        for (int i = 0; i < 4; ++i)
#pragma unroll
          for (int j = 0; j < 8; ++j) KVMEM[(size_t)(tm * 128 + ty * 4 + i) * 512 + tn * 128 + tx * 8 + j] = acc[i][j];
        __syncthreads();
      }
      pg8::Gemm g{1024, 1024, 1024};
      SchedGrid S{(const char*)XB, (const char*)(ws + W_IN) + (size_t)l * IN_PAD * 1024 * 2, (size_t)256 * 1024 * 2, (size_t)256 * 1024 * 2, 64, 27, G, bid};
      EpiProj E{PROJ};
      GEMM_PHASE(EpiProj, SchedGrid, g, S, E);
    }
    GRID_SYNC();
    { PHASE_IDS
      const float* qn = ((const float*)ptab_get(PTAB, 6)) + l * 256; const float* kn = ((const float*)ptab_get(PTAB, 8)) + l * 128;
      for (int r = gw; r < M; r += ngw) {
        const bf16_t* pr = PROJ + (size_t)r * IN_COLS;
        const float posf = (float)((const int*)ptab_get(PTAB, 2))[r];
        float c4[4]; float ss = 0.f;
#pragma unroll
        for (int j = 0; j < 4; ++j) { c4[j] = bf2f(pr[C_CQ + lane + 64 * j]); ss += c4[j] * c4[j]; }
        float rr = rsqrtf(wave_sum(ss) * (1.f / 256.f) + EPS);
#pragma unroll
        for (int j = 0; j < 4; ++j) CQN[(size_t)r * 256 + lane + 64 * j] = f2bf(c4[j] * rr * qn[lane + 64 * j]);
        float d2[2]; ss = 0.f;
#pragma unroll
        for (int j = 0; j < 2; ++j) { d2[j] = bf2f(pr[C_CKV + lane + 64 * j]); ss += d2[j] * d2[j]; }
        rr = rsqrtf(wave_sum(ss) * (1.f / 128.f) + EPS);
#pragma unroll
        for (int j = 0; j < 2; ++j) { CKVN[(size_t)r * 256 + lane + 64 * j] = f2bf(d2[j] * rr * kn[lane + 64 * j]); CKVN[(size_t)r * 256 + 128 + lane + 64 * j] = 0; }
        if (lane < 32) { const int i = lane & 15; const bool hi = lane >= 16; float s_, c_; sincos_big(posf * INV_FREQ[i], s_, c_);
          ROPE[(size_t)r * 32 + lane] = hi ? s_ : c_;
          const float x1 = bf2f(pr[C_KR + i]), x2 = bf2f(pr[C_KR + 16 + i]); const bf16_t v = f2bf(hi ? (x1 * s_ + x2 * c_) : (x1 * c_ - x2 * s_));
#pragma unroll
          for (int h = 0; h < 4; ++h) KM[(size_t)r * 384 + h * 96 + 64 + lane] = v; }
      }
      for (int ci = bid; ci < 1024; ci += G) hgrn_stepA(sm, PROJ, (const float*)ptab_get(PTAB, 4), l, (float*)(ws + WS_HGH), (float*)(ws + WS_HGD), (float*)(ws + WS_HGB), ci, tid);
    }
    GRID_SYNC();
    { PHASE_IDS
      for (int pb = bid; pb < 256; pb += G) hgrn_stepB(sm, (const float*)(ws + WS_HGH), (const float*)(ws + WS_HGD), (float*)(ws + WS_HGS), pb, tid);
      pg8::Gemm g{256, 256, 256};
      SchedUp S{(const char*)CQN, (const char*)(ws + W_UQ) + (size_t)l * 512 * 256 * 2, (const char*)CKVN, (const char*)(ws + W_UKV) + (size_t)l * 512 * 256 * 2, G, bid};
      EpiUp E{QM, KM, VM, ROPE};
      GEMM_PHASE(EpiUp, SchedUp, g, S, E);
    }
    GRID_SYNC();
    { PHASE_IDS
      int* ubox = (int*)(sm + 30000);
      const int rowi = tid >> 1, half = tid & 1;
      for (;;) {
        __syncthreads();
        if (tid == 0) *ubox = (int)atomicAdd(ctl + CW_UNIT + 64 * l, 1u);
        __syncthreads();
        const int u0 = *ubox;
        if (u0 >= 512) break;
        const int u = u0 + 264;
        if (u < 256) {
        } else if (u < 264) {
        } else if (u < 520) {
          const int v_ = u - 264, qb = v_ >> 3, bh = v_ & 7, b = bh >> 2, h = bh & 3;
          const int t = qb * 256 + rowi; const size_t r = (size_t)b * SEQ + t;
          float q[32], o[32];
#pragma unroll
          for (int d = 0; d < 32; ++d) { q[d] = bf2f(PROJ[r * IN_COLS + C_SBQ + h * 64 + half * 32 + d]) * 0.125f; o[d] = 0.f; }
          float run = 0.f;
          float* sK = sm; float* sV = sm + 1024;
          for (int kt = (qb * 256 + 255) / 16; kt >= 0; --kt) {
            __syncthreads();
            for (int e = tid; e < 1024; e += NT) { const int j = e >> 6, d = e & 63; const bf16_t* pr = PROJ + ((size_t)b * SEQ + kt * 16 + j) * IN_COLS;
              sK[e] = bf2f(pr[C_SBK + h * 64 + d]); sV[e] = bf2f(pr[C_SBV + h * 64 + d]); }
            __syncthreads();
#pragma unroll 1
            for (int j = 15; j >= 0; --j) { float z = 0.f;
#pragma unroll
              for (int d = 0; d < 32; ++d) z += q[d] * sK[j * 64 + half * 32 + d];
              z += __shfl_xor(z, 1);
              const bool valid = (kt * 16 + j) < t;
              const float lsz = logsigf_(z); const float a = valid ? expf(lsz + run) : 0.f;
#pragma unroll
              for (int d = 0; d < 32; ++d) o[d] += a * sV[j * 64 + half * 32 + d];
              run += valid ? (lsz - z) : 0.f; }
            const int done = ((run < -88.0f) || (kt == 0)) ? 1 : 0;
            __syncthreads(); if (tid == 0) ubox[1] = 1; __syncthreads(); if (!done) ubox[1] = 0; __syncthreads();
            if (ubox[1]) break;
          }
#pragma unroll
          for (int d = 0; d < 32; ++d) Y[r * DM + 768 + h * 64 + half * 32 + d] = f2bf(o[d]);
        } else {
          const int v_ = u - 520, qb = v_ >> 3, bh = v_ & 7, b = bh >> 2, h = bh & 3, kvh = h >> 1;
          const int t = qb * 256 + rowi; const size_t r = (size_t)b * SEQ + t;
          const int pq = ((const int*)ptab_get(PTAB, 2))[r];
          float q[32], o[32];
#pragma unroll
          for (int d = 0; d < 32; ++d) { q[d] = bf2f(PROJ[r * IN_COLS + C_SWQ + h * 64 + half * 32 + d]) * 0.125f; o[d] = 0.f; }
          float mrun = ((const float*)ptab_get(PTAB, 10))[l * 4 + h], lrun = 1.f;
          float* sK = sm; float* sV = sm + 1024; int* sP = (int*)(sm + 2048);
          int k0 = qb * 256 - 127; if (k0 < 0) k0 = 0;
          for (int kt = k0 / 16; kt <= (qb * 256 + 255) / 16; ++kt) {
            __syncthreads();
            for (int e = tid; e < 1024; e += NT) { const int j = e >> 6, d = e & 63; const bf16_t* pr = PROJ + ((size_t)b * SEQ + kt * 16 + j) * IN_COLS;
              sK[e] = bf2f(pr[C_SWK + kvh * 64 + d]); sV[e] = bf2f(pr[C_SWV + kvh * 64 + d]); }
            if (tid < 16) sP[tid] = ((const int*)ptab_get(PTAB, 2))[(size_t)b * SEQ + kt * 16 + tid];
            __syncthreads();
#pragma unroll 1
            for (int j = 0; j < 16; ++j) { float a = 0.f;
#pragma unroll
              for (int d = 0; d < 32; ++d) a += q[d] * sK[j * 64 + half * 32 + d];
              a += __shfl_xor(a, 1);
              const int key = kt * 16 + j; const bool valid = (key <= t) && (key >= t - 127);
              a += ((const float*)ptab_get(PTAB, 3))[rel_bucket(pq - sP[j]) * 4 + h];
              if (valid) {
                const float mn = fmaxf(mrun, a), al = expf(mrun - mn), pj = expf(a - mn);
                lrun = lrun * al + pj; mrun = mn;
#pragma unroll
                for (int d = 0; d < 32; ++d) o[d] = o[d] * al + pj * sV[j * 64 + half * 32 + d];
              } }
          }
          const float inv = 1.f / lrun;
#pragma unroll
          for (int d = 0; d < 32; ++d) Y[r * DM + 256 + h * 64 + half * 32 + d] = f2bf(o[d] * inv);
        }
      }
    }
    { PHASE_IDS
      for (int ci = bid; ci < 1024; ci += G) hgrn_stepC(sm, PROJ, (const float*)ptab_get(PTAB, 4), (const float*)ptab_get(PTAB, 11), l, (const float*)(ws + WS_HGB), (const float*)(ws + WS_HGS), Y, ci, tid);
    }
    { PHASE_IDS
      const int vcu = (G % 8 == 0) ? (bid % 8) * (G / 8) + bid / 8 : bid;
      for (int pu = vcu; pu < 256; pu += G) { const int bh = pu >> 5, j = pu & 31;
        mla_unit(lds3, QM, KM, VM, Y, bh >> 2, bh & 3, 63 - j, tid);
        mla_unit(lds3, QM, KM, VM, Y, bh >> 2, bh & 3, j, tid); }
    }
    GRID_SYNC();
    { PHASE_IDS
      pg8::Gemm g{1024, 256, 256};
      SchedBranch S{(const char*)Y, (const char*)(ws + W_BR) + (size_t)l * 4 * 1024 * 256 * 2, G, bid};
      EpiMerge E{PROJ, T, MB};
      GEMM_PHASE(EpiMerge, SchedBranch, g, S, E);
    }
    GRID_SYNC();
    { PHASE_IDS
      pg8::Gemm g{1024, 1024, 1024};
      SchedGrid S{(const char*)MB, (const char*)(ws + W_OUT) + (size_t)l * 1024 * 1024 * 2, (size_t)256 * 1024 * 2, (size_t)256 * 1024 * 2, 64, 4, G, bid};
      EpiRes E{(l == 0) ? ((const float*)ptab_get(PTAB, 0)) : (const float*)X, T};
      GEMM_PHASE(EpiRes, SchedGrid, g, S, E);
    }
    GRID_SYNC();
    { PHASE_IDS ln_rows(T, X, XB, ((const float*)ptab_get(PTAB, 14)) + (l * 3 + 0) * DM, ((const float*)ptab_get(PTAB, 15)) + (l * 3 + 0) * DM, gw, ngw, lane); }
    GRID_SYNC();
    { PHASE_IDS
      pg8::Gemm g{1024, 1024, 1024};
      SchedGrid S{(const char*)XB, (const char*)(ws + W_XQ) + (size_t)l * 256 * 1024 * 2, (size_t)256 * 1024 * 2, (size_t)256 * 1024 * 2, 64, 1, G, bid};
      EpiBf E{XQ, 256, 0.125f};
      GEMM_PHASE(EpiBf, SchedGrid, g, S, E);
    }
    GRID_SYNC();
    { PHASE_IDS
      const int rowi = tid >> 1, half = tid & 1;
      for (int u = bid; u < 256; u += G) {
        const int qb = u >> 3, bh = u & 7, b = bh >> 2, h = bh & 3;
        const size_t r = (size_t)b * SEQ + qb * 256 + rowi;
        float q[32], o[32];
#pragma unroll
        for (int d = 0; d < 32; ++d) { q[d] = bf2f(XQ[r * 256 + h * 64 + half * 32 + d]); o[d] = 0.f; }
        float mrun = -1e30f, lrun = 0.f;
        float* sK = sm; float* sV = sm + 1024;
        for (int kt = 0; kt < 16; ++kt) {
          __syncthreads();
          for (int e = tid; e < 1024; e += NT) { const int j = e >> 6, d = e & 63; const float* kr = KVMEM + (size_t)(b * 256 + kt * 16 + j) * 512;
            sK[e] = kr[h * 64 + d]; sV[e] = kr[256 + h * 64 + d]; }
          __syncthreads();
#pragma unroll 1
          for (int j = 0; j < 16; ++j) { float a = 0.f;
#pragma unroll
            for (int d = 0; d < 32; ++d) a += q[d] * sK[j * 64 + half * 32 + d];
            a += __shfl_xor(a, 1);
            const float mn = fmaxf(mrun, a), al = expf(mrun - mn), pj = expf(a - mn);
            lrun = lrun * al + pj; mrun = mn;
#pragma unroll
            for (int d = 0; d < 32; ++d) o[d] = o[d] * al + pj * sV[j * 64 + half * 32 + d]; }
        }
        const float inv = 1.f / lrun;
#pragma unroll
        for (int d = 0; d < 32; ++d) XO[r * 256 + h * 64 + half * 32 + d] = f2bf(o[d] * inv);
        __syncthreads();
      }
    }
    GRID_SYNC();
    { PHASE_IDS
      pg8::Gemm g{256, 256, 256};
      SchedGrid S{(const char*)XO, (const char*)(ws + W_XO) + (size_t)l * 1024 * 256 * 2, (size_t)256 * 256 * 2, (size_t)256 * 256 * 2, 64, 4, G, bid};
      EpiRes E{X, T};
      GEMM_PHASE(EpiRes, SchedGrid, g, S, E);
    }
    GRID_SYNC();
    { PHASE_IDS ln_rows(T, X, XB, ((const float*)ptab_get(PTAB, 14)) + (l * 3 + 1) * DM, ((const float*)ptab_get(PTAB, 15)) + (l * 3 + 1) * DM, gw, ngw, lane); }
    GRID_SYNC();
    if (l == 0) {
      { PHASE_IDS
        pg8::Gemm g{1024, 1024, 1024};
        SchedGrid S{(const char*)XB, (const char*)(ws + W_F13), (size_t)256 * 1024 * 2, (size_t)256 * 1024 * 2, 64, 22, G, bid};
        EpiSwiGLU E{H2, F_DENSE};
        GEMM_PHASE(EpiSwiGLU, SchedGrid, g, S, E);
      }
      GRID_SYNC();
      { PHASE_IDS
        pg8::Gemm g{F_DENSE, F_DENSE, F_DENSE};
        SchedGrid S{(const char*)H2, (const char*)(ws + W_F2), (size_t)256 * F_DENSE * 2, (size_t)256 * F_DENSE * 2, 64, 4, G, bid};
        EpiRes E{X, T};
        GEMM_PHASE(EpiRes, SchedGrid, g, S, E);
      }
      GRID_SYNC();
      { PHASE_IDS ln_rows(T, X, XB, ((const float*)ptab_get(PTAB, 14)) + (l * 3 + 2) * DM, ((const float*)ptab_get(PTAB, 15)) + (l * 3 + 2) * DM, gw, ngw, lane); }
      GRID_SYNC();
    } else {
      { PHASE_IDS
        for (int r = gw; r < M; r += ngw) {
          float lg[8];
#pragma unroll
          for (int e = 0; e < 8; ++e) lg[e] = 0.f;
          for (int j = 0; j < 16; ++j) { const int k = lane + 64 * j; const float xv = X[(size_t)r * DM + k];
            const f32x4 w0 = *(const f32x4*)(((const float*)ptab_get(PTAB, 21)) + (size_t)k * 8), w1 = *(const f32x4*)(((const float*)ptab_get(PTAB, 21)) + (size_t)k * 8 + 4);
            lg[0] += xv * w0[0]; lg[1] += xv * w0[1]; lg[2] += xv * w0[2]; lg[3] += xv * w0[3]; lg[4] += xv * w1[0]; lg[5] += xv * w1[1]; lg[6] += xv * w1[2]; lg[7] += xv * w1[3]; }
#pragma unroll
          for (int e = 0; e < 8; ++e) lg[e] = wave_sum(lg[e]);
          int e0 = 0; float v0 = lg[0];
#pragma unroll
          for (int e = 1; e < 8; ++e) if (lg[e] > v0) { v0 = lg[e]; e0 = e; }
          int e1 = -1; float v1 = -3.0e38f;
#pragma unroll
          for (int e = 0; e < 8; ++e) if (e != e0 && lg[e] > v1) { v1 = lg[e]; e1 = e; }
          if (lane == 0) {
            const float w1_ = 1.f / (1.f + expf(v0 - v1)), w0_ = 1.f - w1_;
            const int p0 = (int)atomicAdd(ctl + CW_CNT + e0, 1u), p1 = (int)atomicAdd(ctl + CW_CNT + e1, 1u);
            tok_e[2 * r] = e0; tok_e[2 * r + 1] = e1; tok_p[2 * r] = p0; tok_p[2 * r + 1] = p1; tok_w[2 * r] = w0_; tok_w[2 * r + 1] = w1_;
          }
        }
      }
      GRID_SYNC();
      int pstart[9];
      { PHASE_IDS
        int cnt[8]; int a = 0;
#pragma unroll
        for (int e = 0; e < 8; ++e) { pstart[e] = a; cnt[e] = __builtin_amdgcn_readfirstlane((int)__hip_atomic_load(ctl + CW_CNT + e, __ATOMIC_RELAXED, __HIP_MEMORY_SCOPE_AGENT)); a += (cnt[e] + 255) / 256 * 256; }
        pstart[8] = a;
        for (int i = gw; i < 2 * M; i += ngw) { const int e = tok_e[i];
          int st = 0;
#pragma unroll
          for (int q = 0; q < 8; ++q) if (q == e) st = pstart[q];
          const int dest = st + tok_p[i]; if (lane == 0) tok_slot[i] = dest;
          const u32x4* src = (const u32x4*)(XB + (size_t)(i >> 1) * DM); u32x4* dst = (u32x4*)(XG + (size_t)dest * DM);
          dst[lane] = src[lane]; dst[lane + 64] = src[lane + 64]; }
        for (int e = 0; e < 8; ++e) { const int r0 = pstart[e] + cnt[e], r1 = pstart[e + 1];
          for (int rr = r0 + gw; rr < r1; rr += ngw) { u32x4* dst = (u32x4*)(XG + (size_t)rr * DM); dst[lane] = (u32x4){0u, 0u, 0u, 0u}; dst[lane + 64] = (u32x4){0u, 0u, 0u, 0u}; } }
      }
      GRID_SYNC();
      { PHASE_IDS
        pg8::Gemm g{1024, 1024, 1024};
        SchedMoE S{(const char*)XG, (const char*)(ws + W_M13), (size_t)256 * 1024 * 2, (size_t)256 * 1024 * 2, (size_t)2 * F_EXP * 1024 * 2, pstart[8] / 256, 28, G, bid,
                   pstart[1], pstart[2], pstart[3], pstart[4], pstart[5], pstart[6], pstart[7]};
        EpiSwiGLU E{H2, F_EXP};
        GEMM_PHASE(EpiSwiGLU, SchedMoE, g, S, E);
      }
      GRID_SYNC();
      { PHASE_IDS
        pg8::Gemm g{F_EXP, F_EXP, F_EXP};
        SchedMoE S{(const char*)H2, (const char*)(ws + W_M2), (size_t)256 * F_EXP * 2, (size_t)256 * F_EXP * 2, (size_t)1024 * F_EXP * 2, pstart[8] / 256, 4, G, bid,
                   pstart[1], pstart[2], pstart[3], pstart[4], pstart[5], pstart[6], pstart[7]};
        EpiF32 E{YS};
        GEMM_PHASE(EpiF32, SchedMoE, g, S, E);
      }
      GRID_SYNC();
      { PHASE_IDS
        const float* g = ((const float*)ptab_get(PTAB, 14)) + (l * 3 + 2) * DM; const float* bb_ = ((const float*)ptab_get(PTAB, 15)) + (l * 3 + 2) * DM;
        for (int r = gw; r < M; r += ngw) {
          const int s0 = tok_slot[2 * r], s1 = tok_slot[2 * r + 1]; const float w0 = tok_w[2 * r], w1 = tok_w[2 * r + 1];
          f32x4 v[4]; float s = 0.f;
#pragma unroll
          for (int j = 0; j < 4; ++j) { const f32x4 xv = ((const f32x4*)(X + (size_t)r * DM))[lane + 64 * j];
            const f32x4 y0 = ((const f32x4*)(YS + (size_t)s0 * DM))[lane + 64 * j], y1 = ((const f32x4*)(YS + (size_t)s1 * DM))[lane + 64 * j];
            v[j] = xv * ALPHA + y0 * w0 + y1 * w1; s += (v[j][0] + v[j][1]) + (v[j][2] + v[j][3]); }
          const float mean = wave_sum(s) * (1.f / DM); float s2 = 0.f;
#pragma unroll
          for (int j = 0; j < 4; ++j) { v[j] = v[j] - mean; s2 += (v[j][0] * v[j][0] + v[j][1] * v[j][1]) + (v[j][2] * v[j][2] + v[j][3] * v[j][3]); }
          const float rstd = rsqrtf(wave_sum(s2) * (1.f / DM) + EPS);
          f32x4* o = (f32x4*)(((float*)ptab_get(PTAB, 24)) + (size_t)r * DM) + lane;
#pragma unroll
          for (int j = 0; j < 4; ++j) { const f32x4 gg = ((const f32x4*)g)[lane + 64 * j], bv = ((const f32x4*)bb_)[lane + 64 * j]; o[64 * j] = v[j] * rstd * gg + bv; }
        }
      }
    }
  }
}

#undef ctl
#undef X
#undef T
#undef XB
#undef Y
#undef MB
#undef QM
#undef KM
#undef VM
#undef CQN
#undef CKVN
#undef XQ
#undef XO
#undef ROPE
#undef KVMEM
#undef PROJ
#undef H2
#undef YS
#undef XG
constexpr int LDS_BYTES = 147456;
extern "C" void kernel_launch(void* const* d_in, const int* in_sizes, int n_in, void* d_out, int out_size, void* d_ws, size_t ws_size, hipStream_t stream) {
  static int grid = 0;
  if (grid == 0) {
    int dev = 0, cus = 0, per_cu = 0;
    (void)hipGetDevice(&dev);
    (void)hipDeviceGetAttribute(&cus, hipDeviceAttributeMultiprocessorCount, dev);
    (void)hipFuncSetAttribute((const void*)mega, hipFuncAttributeMaxDynamicSharedMemorySize, LDS_BYTES);
    (void)hipOccupancyMaxActiveBlocksPerMultiprocessor(&per_cu, (const void*)mega, NT, LDS_BYTES);
    if (per_cu < 1) { fprintf(stderr, "occupancy query says %d blocks/CU\n", per_cu); per_cu = 1; }
    if (per_cu > 1) per_cu = 1;
    grid = cus * per_cu;
    if (ws_size < WS_END) { fprintf(stderr, "workspace too small: %zu < %zu\n", ws_size, (size_t)WS_END); grid = -1; }
  }
  if (grid < 0) return;
  (void)hipMemsetAsync((char*)d_ws + WS_CTL, 0, 1 * MiB, stream);
  Params p{};
  const float** f = (const float**)&p;
  for (int i = 0; i < 24; ++i) f[i] = (const float*)d_in[i];
  p.pos = (const int*)d_in[2];
  p.out = (float*)d_out; p.ws = (unsigned char*)d_ws;
  void* args[] = {&p};
  hipError_t e = hipLaunchCooperativeKernel((const void*)mega, dim3(grid), dim3(NT), args, LDS_BYTES, stream);
  if (e != hipSuccess) fprintf(stderr, "cooperative launch failed: %s (grid %d)\n", hipGetErrorString(e), grid);
}
```

```cpp
#include <hip/hip_runtime.h>
#include <hip/hip_cooperative_groups.h>
#include <cstdio>
#include <cstdint>
namespace cg = cooperative_groups;

namespace pg8 {
#define PG8_LAS __attribute__((address_space(3)))
typedef unsigned short bf16_t;
typedef short bf16x8 __attribute__((ext_vector_type(8)));
typedef float f32x4 __attribute__((ext_vector_type(4)));
typedef unsigned u32x4 __attribute__((ext_vector_type(4)));
constexpr int BM = 256, BK = 64, HALF = 128, HTB = HALF * BK * 2  , STAGE_BYTES = 8 * HTB, NXCD = 8, WGM = 8;

__host__ __device__ __forceinline__ int lds_byte(int r, int c) { const int st = (r >> 4) * 2 + (c >> 5), rr = r & 15, cc = c & 31, ob = rr * 64 + cc * 2; return st * 1024 + (ob ^ (((ob >> 9) & 1) << 5)); }
__host__ __device__ __forceinline__ void stage_rc(int b, int& R, int& C) { const int st = b / 1024, sb = b % 1024, swz = sb ^ (((sb >> 9) & 1) << 5); R = (st >> 1) * 16 + swz / 64; C = (st & 1) * 32 + (swz % 64) / 2; }
__host__ __device__ __forceinline__ int perm32(int rho) { const int n = rho >> 4, i = rho & 15; return 8 * (i >> 2) + 4 * n + (i & 3); }


struct Unit { int pm, pn; const char* a; const char* b; int aux; };
struct Gemm { int lda, ldb, K; };
__device__ __forceinline__ void glds16_s(const void* sbase, unsigned voff, unsigned lds_dst) { unsigned keep;
  asm volatile("s_mov_b32 %0, m0\n\ts_mov_b32 m0, %3\n\ts_nop 0\n\tglobal_load_lds_dwordx4 %2, %1\n\ts_mov_b32 m0, %0" : "=&s"(keep) : "s"(sbase), "v"(voff), "s"(lds_dst) : "memory"); }
__device__ __forceinline__ const char* uni_ptr(const char* q) { const unsigned long long v = (unsigned long long)(uintptr_t)q;
  const unsigned lo = __builtin_amdgcn_readfirstlane((unsigned)v), hi = __builtin_amdgcn_readfirstlane((unsigned)(v >> 32)); return (const char*)(uintptr_t)(((unsigned long long)hi << 32) | lo); }
__device__ __forceinline__ unsigned cvt_pk_bf16(float lo, float hi) { unsigned r; asm volatile("v_cvt_pk_bf16_f32 %0, %1, %2" : "=v"(r) : "v"(lo), "v"(hi)); return r; }
template <class Epi, class Sched, bool ALIGN_EPI = false, bool SP2 = false>
__device__ __forceinline__ void gemm_phase(PG8_LAS unsigned char* lds, const Gemm g, const Sched& S, const Epi& E, const int tid_in) {
    int tid_l = tid_in; asm volatile("" : "+v"(tid_l));
    const int tid = tid_l, wid = __builtin_amdgcn_readfirstlane(tid >> 6), lane = tid & 63, wr = wid >> 2, wc = wid & 3, fr = lane & 15, fq = lane >> 4;
    const int K = g.K, nt = K / BK;
    unsigned voffA[2], voffB[2];
#pragma unroll
    for (int i = 0; i < 2; ++i) { int R, C; stage_rc(tid * 16 + i * 8192, R, C); const int Rb = Epi::PERM ? ((R & ~31) + perm32(R & 31)) : R;
        voffA[i] = (unsigned)(R * g.lda + C) * 2u; voffB[i] = (unsigned)(Rb * g.ldb + C) * 2u; }
    const size_t kstep = (size_t)(BK * 2);
    const size_t hstepA = (size_t)HALF * g.lda * 2, hstepB = (size_t)HALF * g.ldb * 2;
    const unsigned ldsb = (unsigned)(uintptr_t)lds;
    const unsigned ldsw = (unsigned)wid * 1024u;
    const int aoff = lds_byte(wr * 64 + fr, fq * 8), boff = lds_byte(wc * 32 + fr, fq * 8);
#define PG8_SA(b, h) (((b) * 2 + (h)) * HTB)
#define PG8_SB(b, h) ((4 + (b) * 2 + (h)) * HTB)
#define PG8_STAGE(bufoff, gbase, voff) do { _Pragma("unroll") for (int _i = 0; _i < 2; ++_i) \
        glds16_s((const void*)(gbase), (voff)[_i], (unsigned)__builtin_amdgcn_readfirstlane((int)(ldsb + (unsigned)(bufoff) + ldsw + (unsigned)(_i * 8192)))); } while (0)
#define PG8_LDA(dst, b, h) do { _Pragma("unroll") for (int m = 0; m < 4; ++m) _Pragma("unroll") for (int k = 0; k < 2; ++k) dst[m][k] = *(const PG8_LAS bf16x8*)(lds + PG8_SA(b, h) + aoff + m * 2048 + k * 1024); } while (0)
#define PG8_LDB(dst, b, h) do { _Pragma("unroll") for (int n = 0; n < 2; ++n) _Pragma("unroll") for (int k = 0; k < 2; ++k) dst[n][k] = *(const PG8_LAS bf16x8*)(lds + PG8_SB(b, h) + boff + n * 2048 + k * 1024); } while (0)
#define PG8_MMA(ai, bj, At, Bt) do { __builtin_amdgcn_s_setprio(1); _Pragma("unroll") for (int m = 0; m < 4; ++m) _Pragma("unroll") for (int n = 0; n < 2; ++n) _Pragma("unroll") for (int k = 0; k < 2; ++k) \
        acc[ai][bj][m][n] = __builtin_amdgcn_mfma_f32_16x16x32_bf16(Bt[n][k], At[m][k], acc[ai][bj][m][n], 0, 0, 0); __builtin_amdgcn_s_setprio(0); } while (0)
#define PG8_WAIT_V(n) asm volatile("s_waitcnt vmcnt(" #n ")" ::: "memory")
#define PG8_WAIT_L(n) asm volatile("s_waitcnt lgkmcnt(" #n ")" ::: "memory")
#define PG8_BAR __builtin_amdgcn_s_barrier()
#define PG8_SCHED __builtin_amdgcn_sched_barrier(0)
    Unit cur, nxt; int ui = 0;
    if (!S.next(0, cur)) return;
    f32x4 acc[2][2][4][2];
#pragma unroll
    for (int a = 0; a < 2; ++a)
#pragma unroll
        for (int b = 0; b < 2; ++b)
#pragma unroll
            for (int m = 0; m < 4; ++m)
#pragma unroll
                for (int n = 0; n < 2; ++n) acc[a][b][m][n] = (f32x4){0.f, 0.f, 0.f, 0.f};
    bf16x8 At[4][2], B0[2][2], B1[2][2];
    const char* cA = uni_ptr(cur.a); const char* cB = uni_ptr(cur.b);
    S.a_ready(cur);
    if constexpr (SP2) {
        PG8_STAGE(PG8_SB(0, 0), cB, voffB); PG8_STAGE(PG8_SB(0, 1), cB + hstepB, voffB); PG8_STAGE(PG8_SA(0, 0), cA, voffA); PG8_STAGE(PG8_SA(0, 1), cA + hstepA, voffA);
        if (wr == 1) PG8_BAR;
        PG8_WAIT_V(2); PG8_BAR;
        PG8_STAGE(PG8_SB(1, 0), cB + kstep, voffB); PG8_STAGE(PG8_SA(1, 0), cA + kstep, voffA); PG8_STAGE(PG8_SB(1, 1), cB + hstepB + kstep, voffB);
        PG8_WAIT_V(6); PG8_BAR;
    } else {
        PG8_STAGE(PG8_SB(0, 0), cB, voffB); PG8_STAGE(PG8_SA(0, 0), cA, voffA); PG8_STAGE(PG8_SB(0, 1), cB + hstepB, voffB); PG8_STAGE(PG8_SA(0, 1), cA + hstepA, voffA);
        if (wr == 1) PG8_BAR;
        PG8_WAIT_V(4); PG8_BAR;
        PG8_STAGE(PG8_SB(1, 0), cB + kstep, voffB); PG8_STAGE(PG8_SA(1, 0), cA + kstep, voffA); PG8_STAGE(PG8_SB(1, 1), cB + hstepB + kstep, voffB);
        PG8_WAIT_V(6); PG8_BAR;
    }
    for (;;) {
        const bool has_next = S.next(ui + 1, nxt);
        const char* nA = has_next ? uni_ptr(nxt.a) : cA; const char* nB = has_next ? uni_ptr(nxt.b) : cB;
#pragma nounroll
        for (int t = 0; t < nt; t += 2) {
            const bool last = (t == nt - 2);
            const char* a1 = cA + (size_t)(t + 1) * kstep;
            const char* a2 = last ? nA : cA + (size_t)(t + 2) * kstep; const char* b2 = last ? nB : cB + (size_t)(t + 2) * kstep;
            const char* a3 = a2 + kstep; const char* b3 = b2 + kstep;
            if (last && has_next) S.a_ready(nxt);
            if constexpr (SP2) {
            PG8_LDB(B0, 0, 0); PG8_LDB(B1, 0, 1); PG8_SCHED; PG8_LDA(At, 0, 0); PG8_STAGE(PG8_SA(1, 1), a1 + hstepA, voffA);
            PG8_WAIT_V(8); PG8_WAIT_L(0); PG8_BAR; PG8_MMA(0, 0, At, B0); PG8_MMA(0, 1, At, B1); PG8_BAR; PG8_SCHED;
            PG8_LDA(At, 0, 1); PG8_STAGE(PG8_SB(0, 0), b2, voffB); PG8_STAGE(PG8_SB(0, 1), b2 + hstepB, voffB); PG8_STAGE(PG8_SA(0, 0), a2, voffA);
            PG8_WAIT_V(8); PG8_WAIT_L(0); PG8_BAR; PG8_MMA(1, 0, At, B0); PG8_MMA(1, 1, At, B1); PG8_BAR; PG8_SCHED;
            PG8_LDB(B0, 1, 0); PG8_LDB(B1, 1, 1); PG8_SCHED; PG8_LDA(At, 1, 0); PG8_STAGE(PG8_SA(0, 1), a2 + hstepA, voffA);
            PG8_WAIT_V(8); PG8_WAIT_L(0); PG8_BAR; PG8_MMA(0, 0, At, B0); PG8_MMA(0, 1, At, B1); PG8_BAR; PG8_SCHED;
            PG8_LDA(At, 1, 1); PG8_STAGE(PG8_SB(1, 0), b3, voffB); PG8_STAGE(PG8_SB(1, 1), b3 + hstepB, voffB); PG8_STAGE(PG8_SA(1, 0), a3, voffA);
            PG8_WAIT_V(8); PG8_WAIT_L(0); PG8_BAR; PG8_MMA(1, 0, At, B0); PG8_MMA(1, 1, At, B1); PG8_BAR; PG8_SCHED;
            } else {
            PG8_LDB(B0, 0, 0); PG8_SCHED; PG8_LDA(At, 0, 0); PG8_STAGE(PG8_SA(1, 1), a1 + hstepA, voffA);
            PG8_WAIT_L(8); PG8_BAR; PG8_WAIT_L(0); PG8_MMA(0, 0, At, B0); PG8_BAR; PG8_SCHED;
            PG8_LDB(B1, 0, 1); PG8_STAGE(PG8_SB(0, 0), b2, voffB);
            PG8_BAR; PG8_WAIT_L(0); PG8_MMA(0, 1, At, B1); PG8_BAR;
            PG8_LDA(At, 0, 1); PG8_STAGE(PG8_SA(0, 0), a2, voffA);
            PG8_BAR; PG8_WAIT_L(0); PG8_MMA(1, 0, At, B0); PG8_BAR; PG8_SCHED;
            PG8_STAGE(PG8_SB(0, 1), b2 + hstepB, voffB);
            PG8_WAIT_V(6); PG8_BAR; PG8_MMA(1, 1, At, B1); PG8_BAR;
            PG8_LDB(B0, 1, 0); PG8_SCHED; PG8_LDA(At, 1, 0); PG8_STAGE(PG8_SA(0, 1), a2 + hstepA, voffA);
            PG8_WAIT_L(8); PG8_BAR; PG8_WAIT_L(0); PG8_MMA(0, 0, At, B0); PG8_BAR; PG8_SCHED;
            PG8_LDB(B1, 1, 1); PG8_STAGE(PG8_SB(1, 0), b3, voffB);
            PG8_BAR; PG8_WAIT_L(0); PG8_MMA(0, 1, At, B1); PG8_BAR;
            PG8_LDA(At, 1, 1); PG8_STAGE(PG8_SA(1, 0), a3, voffA);
            PG8_BAR; PG8_WAIT_L(0); PG8_MMA(1, 0, At, B0); PG8_BAR; PG8_SCHED;
            PG8_STAGE(PG8_SB(1, 1), b3 + hstepB, voffB);
            PG8_WAIT_V(6); PG8_BAR; PG8_MMA(1, 1, At, B1); PG8_BAR;
            }
        }
        if constexpr (ALIGN_EPI) { if (wr == 0) PG8_BAR; }
        if constexpr (!Epi::AFTER_DRAIN) { E(acc, cur, wr, wc, fr, fq); S.done(cur); }
        if (!has_next) break;
#pragma unroll
        for (int a = 0; a < 2; ++a)
#pragma unroll
            for (int b = 0; b < 2; ++b)
#pragma unroll
                for (int m = 0; m < 4; ++m)
#pragma unroll
                    for (int n = 0; n < 2; ++n) acc[a][b][m][n] = (f32x4){0.f, 0.f, 0.f, 0.f};
        cur = nxt; cA = nA; cB = nB; ++ui;
        if constexpr (ALIGN_EPI) { if (wr == 1) PG8_BAR; }
    }
    PG8_WAIT_V(0);
    if constexpr (!ALIGN_EPI) { if (wr == 0) PG8_BAR; }
    PG8_BAR;
    if constexpr (Epi::AFTER_DRAIN) { E.fused(acc, cur, wr, wc, fr, fq, lds, wid, lane); S.done(cur); }
#undef PG8_SA
#undef PG8_SB
#undef PG8_STAGE
#undef PG8_LDA
#undef PG8_LDB
#undef PG8_MMA
#undef PG8_WAIT_V
#undef PG8_WAIT_L
#undef PG8_BAR
#undef PG8_SCHED
}
}

typedef unsigned short bf16_t;
typedef float f32x4 __attribute__((ext_vector_type(4)));
typedef unsigned u32x4 __attribute__((ext_vector_type(4)));
typedef unsigned u32x2 __attribute__((ext_vector_type(2)));
#define LAS __attribute__((address_space(3)))

constexpr int DM = 1024, BATCH = 2, SEQ = 8192, M = BATCH * SEQ, DEPTH = 2, MEMLEN = 256;
constexpr int IN_COLS = 6816, IN_PAD = 6912;
constexpr int C_CQ = 0, C_CKV = 256, C_KR = 384, C_SWQ = 416, C_SWK = 672, C_SWV = 800, C_HQ = 928, C_HF = 1184, C_HI = 1440, C_HG = 1696,
              C_SBQ = 1952, C_SBK = 2208, C_SBV = 2464, C_GATE = 2720;
constexpr int F_DENSE = 2816, F_EXP = 3584, NEXP = 8;
constexpr int CAP = 2 * M + NEXP * 256;
constexpr float EPS = 1e-5f;
constexpr float ALPHA = 1.4142135623730951f;
constexpr int NT = 512;

constexpr size_t MiB = 1u << 20;
constexpr size_t WS_CTL = 0;
constexpr size_t WS_X = 1 * MiB;
constexpr size_t WS_T = WS_X + 64 * MiB;
constexpr size_t WS_XB = WS_T + 64 * MiB;
constexpr size_t WS_RA = WS_XB + 32 * MiB;
constexpr size_t WS_Y = WS_RA;
constexpr size_t WS_MB = WS_Y + 32 * MiB;
constexpr size_t WS_QM = WS_MB + 32 * MiB;
constexpr size_t WS_KM = WS_QM + 12 * MiB;
constexpr size_t WS_VM = WS_KM + 12 * MiB;
constexpr size_t WS_CQN = WS_VM + 8 * MiB;
constexpr size_t WS_CKVN = WS_CQN + 8 * MiB;
constexpr size_t WS_XQ = WS_CKVN + 8 * MiB;
constexpr size_t WS_XO = WS_XQ + 8 * MiB;
constexpr size_t WS_ROPE = WS_XO + 8 * MiB;
constexpr size_t WS_YS = WS_RA;
constexpr size_t WS_RA_END = WS_RA + 136 * MiB;
static_assert(WS_ROPE + 2 * MiB <= WS_RA_END, "region A");
constexpr size_t WS_KVMEM = WS_RA_END;
constexpr size_t WS_ROUTE = WS_KVMEM + 1 * MiB;
constexpr size_t WS_XG = WS_ROUTE + 4 * MiB;
constexpr size_t WS_HGH = WS_XG, WS_HGS = WS_XG + 16 * MiB, WS_HGB = WS_XG + 32 * MiB, WS_HGD = WS_XG + 48 * MiB;
constexpr size_t WS_BIG = WS_XG + 68 * MiB;
constexpr size_t WS_W = WS_BIG + 238 * MiB;
constexpr size_t W_IN = WS_W;
constexpr size_t W_UQ = W_IN + (size_t)2 * IN_PAD * 1024 * 2;
constexpr size_t W_UKV = W_UQ + (size_t)2 * 512 * 256 * 2;
constexpr size_t W_BR = W_UKV + (size_t)2 * 512 * 256 * 2;
constexpr size_t W_OUT = W_BR + (size_t)2 * 4 * 1024 * 256 * 2;
constexpr size_t W_XQ = W_OUT + (size_t)2 * 1024 * 1024 * 2;
constexpr size_t W_XO = W_XQ + (size_t)2 * 256 * 1024 * 2;
constexpr size_t W_F13 = W_XO + (size_t)2 * 1024 * 256 * 2;
constexpr size_t W_F2 = W_F13 + (size_t)5632 * 1024 * 2;
constexpr size_t W_M13 = W_F2 + (size_t)1024 * 2816 * 2;
constexpr size_t W_M2 = W_M13 + (size_t)8 * 7168 * 1024 * 2;
constexpr size_t WS_END = W_M2 + (size_t)8 * 1024 * 3584 * 2;
static_assert(WS_END <= (size_t)896 * MiB, "workspace");

constexpr int CW_CNT = 0;
constexpr int CW_UNIT = 64;
constexpr int CW_BAR = 4096;

struct Params {
  const float* x; const float* mem; const int* pos; const float* rel; const float* lbl; const float* w_in;
  const float* qnorm; const float* w_uq; const float* kvnorm; const float* w_ukv; const float* sinks; const float* hnorm;
  const float* w_branch; const float* w_out; const float* ln_g; const float* ln_b; const float* xa_wq; const float* xa_wkv; const float* xa_wo;
  const float* ffn_w13; const float* ffn_w2; const float* router; const float* moe_w13; const float* moe_w2;
  float* out; unsigned char* ws;
};

__device__ __forceinline__ float bf2f(bf16_t v) { return __uint_as_float((unsigned)v << 16); }
__device__ __forceinline__ bf16_t f2bf(float f) { unsigned u = __float_as_uint(f); return (bf16_t)((u + 0x7fffu + ((u >> 16) & 1u)) >> 16); }
__device__ __forceinline__ unsigned pk2(float lo, float hi) { return (unsigned)f2bf(lo) | ((unsigned)f2bf(hi) << 16); }
__device__ __forceinline__ float ldf(const float* p, size_t i) { return p[i]; }
__device__ __forceinline__ float ldf(const bf16_t* p, size_t i) { return bf2f(p[i]); }
__device__ __forceinline__ float sigmoidf_(float x) { return 1.0f / (1.0f + expf(-x)); }
__device__ __forceinline__ float siluf_(float x) { return x / (1.0f + expf(-x)); }
__device__ __forceinline__ float fast_sigmoid(float x) { return __builtin_amdgcn_rcpf(1.0f + __builtin_amdgcn_exp2f(-1.4426950408889634f * x)); }
__device__ __forceinline__ float logsigf_(float z) { return fminf(z, 0.0f) - log1pf(expf(-fabsf(z))); }
__device__ __forceinline__ float wave_sum(float v) {
#pragma unroll
  for (int o = 1; o < 64; o <<= 1) v += __shfl_xor(v, o);
  return v;
}
__device__ __forceinline__ int rel_bucket(int d) {
  int n = d > 0 ? d : 0;
  if (n < 16) return n;
  float nf = (float)n;
  int large = 16 + (int)(logf(nf / 16.0f) / 2.0794415416798357f * 16.0f);
  large = large < 0 ? 0 : (large > 31 ? 31 : large);
  return large;
}
__device__ const float INV_FREQ[16] = {1.0f, 0.5623413251903491f, 0.31622776601683794f, 0.1778279410038923f, 0.1f, 0.05623413251903491f, 0.031622776601683794f,
  0.01778279410038923f, 0.01f, 0.005623413251903491f, 0.0031622776601683794f, 0.001778279410038923f, 0.001f, 0.0005623413251903491f,
  0.00031622776601683794f, 0.0001778279410038923f};
__device__ __forceinline__ void sincos_big(float ang, float& s, float& c) {
  double rev = (double)ang * 0.15915494309189535;
  rev = rev - rint(rev);
  float fr = (float)rev;
  s = __builtin_amdgcn_sinf(fr); c = __builtin_amdgcn_cosf(fr);
}
__device__ __forceinline__ void* ptab_get(LAS const unsigned long long* tab, int i) {
  const unsigned long long v = tab[i]; const unsigned lo = __builtin_amdgcn_readfirstlane((unsigned)v), hi = __builtin_amdgcn_readfirstlane((unsigned)(v >> 32));
  return (void*)(uintptr_t)(((unsigned long long)hi << 32) | lo); }
__device__ __forceinline__ int launder(int v) { asm volatile("" : "+v"(v)); return v; }
__device__ __forceinline__ int launder_s(int v) { asm volatile("" : "+s"(v)); return v; }
__device__ __forceinline__ LAS unsigned char* launder_lds(LAS unsigned char* q) { unsigned v = (unsigned)(uintptr_t)q; asm volatile("" : "+s"(v)); return (LAS unsigned char*)(uintptr_t)v; }
#define PHASE_IDS const int bid = launder_s(bid0), G = launder_s(G0), ngw = G * 8; LAS unsigned char* lds3 = launder_lds(lds30); \
  LAS const unsigned long long* PTAB = (LAS const unsigned long long*)(lds3 + 131072 + 1024); unsigned char* ws = (unsigned char*)ptab_get(PTAB, 25); \
  const int tid = launder(launder_s(wave0) * 64 + (int)__builtin_amdgcn_mbcnt_hi(~0u, __builtin_amdgcn_mbcnt_lo(~0u, 0u))), lane = tid & 63, wave = tid >> 6, gw = bid * 8 + wave, ty = tid >> 4, tx = tid & 15; (void)lane; (void)wave; (void)gw; (void)ty; (void)tx; (void)ngw; (void)ws;

template <typename TA, bool DUAL>
__device__ __forceinline__ void tile_mm(float (&acc)[4][8], float (&acc2)[4][8], const TA* A, int lda, const int* ridx, int row0,
                                        const float* B, const float* B2, int ldb, int col0, int N, int K, float* sm, const int tid_in) {
  float* sA = sm; float* sB = sm + 16 * 132; float* sB2 = sm + 32 * 132;
  const int tid = launder(tid_in), ty = tid >> 4, tx = tid & 15;
  const int ar = tid >> 2, ak = (tid & 3) * 4;
  const int bk = tid >> 5, bc = (tid & 31) * 4;
  long arow = ridx ? (long)ridx[row0 + ar] : (long)(row0 + ar);
#pragma unroll
  for (int i = 0; i < 4; ++i)
#pragma unroll
    for (int j = 0; j < 8; ++j) { acc[i][j] = 0.f; acc2[i][j] = 0.f; }
  const bool bval = (col0 + bc) < N;
  for (int k0 = 0; k0 < K; k0 += 16) {
    float a0 = 0.f, a1 = 0.f, a2 = 0.f, a3 = 0.f;
    if (arow >= 0) { const size_t o = (size_t)arow * lda + k0 + ak; a0 = ldf(A, o); a1 = ldf(A, o + 1); a2 = ldf(A, o + 2); a3 = ldf(A, o + 3); }
    f32x4 b = {0.f, 0.f, 0.f, 0.f}, b2 = {0.f, 0.f, 0.f, 0.f};
    if (bval) { b = *(const f32x4*)(B + (size_t)(k0 + bk) * ldb + col0 + bc); if (DUAL) b2 = *(const f32x4*)(B2 + (size_t)(k0 + bk) * ldb + col0 + bc); }
    __syncthreads();
    sA[(ak + 0) * 132 + ar] = a0; sA[(ak + 1) * 132 + ar] = a1; sA[(ak + 2) * 132 + ar] = a2; sA[(ak + 3) * 132 + ar] = a3;
    *(f32x4*)&sB[bk * 132 + bc] = b;
    if (DUAL) *(f32x4*)&sB2[bk * 132 + bc] = b2;
    __syncthreads();
#pragma unroll 4
    for (int kk = 0; kk < 16; ++kk) {
      const f32x4 a = *(const f32x4*)&sA[kk * 132 + ty * 4];
      const f32x4 p = *(const f32x4*)&sB[kk * 132 + tx * 8], q = *(const f32x4*)&sB[kk * 132 + tx * 8 + 4];
#pragma unroll
      for (int i = 0; i < 4; ++i) {
        acc[i][0] += a[i] * p[0]; acc[i][1] += a[i] * p[1]; acc[i][2] += a[i] * p[2]; acc[i][3] += a[i] * p[3];
        acc[i][4] += a[i] * q[0]; acc[i][5] += a[i] * q[1]; acc[i][6] += a[i] * q[2]; acc[i][7] += a[i] * q[3];
      }
      if (DUAL) {
        const f32x4 p2 = *(const f32x4*)&sB2[kk * 132 + tx * 8], q2 = *(const f32x4*)&sB2[kk * 132 + tx * 8 + 4];
#pragma unroll
        for (int i = 0; i < 4; ++i) {
          acc2[i][0] += a[i] * p2[0]; acc2[i][1] += a[i] * p2[1]; acc2[i][2] += a[i] * p2[2]; acc2[i][3] += a[i] * p2[3];
          acc2[i][4] += a[i] * q2[0]; acc2[i][5] += a[i] * q2[1]; acc2[i][6] += a[i] * q2[2]; acc2[i][7] += a[i] * q2[3];
        }
      }
    }
  }
  __syncthreads();
}


#define XB_TMO      128
#define XB_XCNT(j)  (256  + 64 * (j))
#define XB_XSUB(j)  (1280 + 64 * (j))
#define XB_XGEN(j)  (2304 + 64 * (j))
#define XB_TOP      3328
#define XB_TOPGEN   3392
#define XCD_BAR_WORDS 3456
#define XB_SPIN_CAP (1u << 18)

__device__ __forceinline__ unsigned xb_ld(unsigned* p)              { return __hip_atomic_load(p, __ATOMIC_RELAXED, __HIP_MEMORY_SCOPE_AGENT); }
__device__ __forceinline__ unsigned xb_add(unsigned* p, unsigned v) { return __hip_atomic_fetch_add(p, v, __ATOMIC_RELAXED, __HIP_MEMORY_SCOPE_AGENT); }
__device__ __forceinline__ unsigned xb_xcc_id() { return (unsigned)__builtin_amdgcn_s_getreg((3 << 11) | 20) & 0xFu; }
#define XB_SPIN(cond, bar) do { unsigned _sp = 0; while (cond) { __builtin_amdgcn_s_sleep(1); \
    if ((++_sp & 255u) == 0u) { if (xb_ld(&(bar)[XB_TMO])) break; if (_sp > XB_SPIN_CAP) { atomicAdd(&(bar)[XB_TMO], 1u); break; } } } } while (0)

struct XcdBarrier {
    unsigned* bar; unsigned x;
    volatile LAS unsigned* st;
};

__device__ __forceinline__ XcdBarrier xcd_barrier_post(unsigned* bar, volatile LAS unsigned* st) {
    XcdBarrier b; b.bar = bar; b.x = xb_xcc_id(); b.st = st;
    if (threadIdx.x == 0) (void)xb_add(&bar[XB_XCNT(b.x)], 1u);
    return b;
}
__device__ __forceinline__ void xcd_barrier_complete(unsigned* bar, unsigned x, unsigned& nloc, unsigned& nx) {
    const unsigned G = gridDim.x * gridDim.y * gridDim.z;
    unsigned sum, cnt, mine, sp = 0u;
    for (;;) {
        sum = 0u; cnt = 0u; mine = 0u;
#pragma unroll
        for (unsigned j = 0; j < 16; ++j) { const unsigned c = xb_ld(&bar[XB_XCNT(j)]); sum += c; cnt += (c > 0u) ? 1u : 0u; mine = (j == x) ? c : mine; }
        if (sum == G) break;
        __builtin_amdgcn_s_sleep(1);
        if ((++sp & 255u) == 0u) { if (xb_ld(&bar[XB_TMO])) break; if (sp > XB_SPIN_CAP) { atomicAdd(&bar[XB_TMO], 1u); break; } }
    }
    nloc = mine > 0u ? mine : 1u; nx = cnt > 0u ? cnt : 1u;
}

__device__ __forceinline__ void xcd_barrier(const XcdBarrier& b, const int tid) {
    asm volatile("s_waitcnt vmcnt(0)" ::: "memory");
    __syncthreads();
    if (tid == 0) {
        unsigned* bar = b.bar;
        __builtin_amdgcn_s_waitcnt(0);
        unsigned nloc = b.st[0], nx = b.st[1];
        if (nloc == 0u) { xcd_barrier_complete(bar, b.x, nloc, nx); b.st[0] = nloc; b.st[1] = nx; }
        const unsigned old = xb_add(&bar[XB_XSUB(b.x)], 1u);
        const unsigned gen = old / nloc;
        if (old + 1u == (gen + 1u) * nloc) {
            __builtin_amdgcn_fence(__ATOMIC_RELEASE, "agent");
            asm volatile("s_waitcnt vmcnt(0)" ::: "memory");
            const unsigned og = xb_add(&bar[XB_TOP], 1u);
            const unsigned tg = og / nx;
            if (og + 1u == (tg + 1u) * nx) xb_add(&bar[XB_TOPGEN], 1u);
            else XB_SPIN(xb_ld(&bar[XB_TOPGEN]) == tg, bar);
            __builtin_amdgcn_fence(__ATOMIC_ACQUIRE, "agent");
            xb_add(&bar[XB_XGEN(b.x)], 1u);
            asm volatile("s_waitcnt vmcnt(0)" ::: "memory");
        } else {
            XB_SPIN(xb_ld(&bar[XB_XGEN(b.x)]) == gen, bar);
            __builtin_amdgcn_fence(__ATOMIC_ACQUIRE, "agent");
            asm volatile("s_waitcnt vmcnt(0)" ::: "memory");
        }
    }
    __syncthreads();
}

__device__ __forceinline__ bool tile_of(long L, int nM, int nN, int& pm, int& pn) {
  const int nwg = nM * nN; if (L >= nwg) return false;
  int wgid = (int)L; { const int q = nwg / 8, r = nwg % 8, xcd = wgid % 8, off = wgid / 8; wgid = (xcd < r ? xcd * (q + 1) : r * (q + 1) + (xcd - r) * q) + off; }
  const int nig = 8 * nN, gid = wgid / nig, fm = gid * 8, gsz = (nM - fm) < 8 ? (nM - fm) : 8;
  pm = fm + ((wgid % nig) % gsz); pn = (wgid % nig) / gsz; return true;
}
struct SchedGrid {
  const char* A; const char* B; size_t at, bt; int nM, nN, G, c;
  __device__ __forceinline__ bool next(int i, pg8::Unit& u) const { int pm, pn; if (!tile_of((long)i * G + c, nM, nN, pm, pn)) return false;
    u.pm = pm; u.pn = pn; u.a = A + (size_t)pm * at; u.b = B + (size_t)pn * bt; u.aux = 0; return true; }
  __device__ __forceinline__ void a_ready(const pg8::Unit&) const {}
  __device__ __forceinline__ void done(const pg8::Unit&) const {}
};
struct SchedUp {
  const char* A0; const char* B0; const char* A1; const char* B1; int G, c;
  __device__ __forceinline__ bool next(int i, pg8::Unit& u) const { const int L = i * G + c; if (L >= 256) return false;
    const int grp = L >> 7, t = L & 127; u.pm = t >> 1; u.pn = t & 1; u.aux = grp;
    u.a = (grp ? A1 : A0) + (size_t)u.pm * (256 * 256 * 2); u.b = (grp ? B1 : B0) + (size_t)u.pn * (256 * 256 * 2); return true; }
  __device__ __forceinline__ void a_ready(const pg8::Unit&) const {}
  __device__ __forceinline__ void done(const pg8::Unit&) const {}
};
struct SchedBranch {
  const char* Y; const char* W; int G, c;
  __device__ __forceinline__ bool next(int i, pg8::Unit& u) const { int pm, pn; if (!tile_of((long)(i >> 2) * G + c, 64, 4, pm, pn)) return false;
    const int n = i & 3; u.pm = pm; u.pn = pn; u.aux = n;
    u.a = Y + (size_t)pm * (256 * 1024 * 2) + n * 512; u.b = W + (size_t)n * (1024 * 256 * 2) + (size_t)pn * (256 * 256 * 2); return true; }
  __device__ __forceinline__ void a_ready(const pg8::Unit&) const {}
  __device__ __forceinline__ void done(const pg8::Unit&) const {}
};
struct SchedMoE {
  const char* A; const char* B; size_t at, bt, be; int nM, nN, G, c; int ps1, ps2, ps3, ps4, ps5, ps6, ps7;
  __device__ __forceinline__ bool next(int i, pg8::Unit& u) const { int pm, pn; if (!tile_of((long)i * G + c, nM, nN, pm, pn)) return false;
    const int r0 = pm * 256; const int e = (r0 >= ps1) + (r0 >= ps2) + (r0 >= ps3) + (r0 >= ps4) + (r0 >= ps5) + (r0 >= ps6) + (r0 >= ps7);
    u.pm = pm; u.pn = pn; u.aux = e; u.a = A + (size_t)pm * at; u.b = B + (size_t)e * be + (size_t)pn * bt; return true; }
  __device__ __forceinline__ void a_ready(const pg8::Unit&) const {}
  __device__ __forceinline__ void done(const pg8::Unit&) const {}
};

typedef const pg8::f32x4 (&AccRef)[2][2][4][2];
struct EpiProj { static constexpr bool PERM = true, AFTER_DRAIN = false; bf16_t* O;
  __device__ __forceinline__ void operator()(AccRef acc, const pg8::Unit& u, int wr, int wc, int fr, int fq) const {
    const int row0 = u.pm * 256 + wr * 64 + fr;
#pragma unroll
    for (int ai = 0; ai < 2; ++ai)
#pragma unroll
      for (int m = 0; m < 4; ++m) { bf16_t* rowp = O + (size_t)(row0 + ai * 128 + m * 16) * IN_COLS;
#pragma unroll
        for (int bj = 0; bj < 2; ++bj) { const int c0 = u.pn * 256 + bj * 128 + wc * 32 + 8 * fq;
          if (c0 < IN_COLS) { pg8::f32x4 v0 = acc[ai][bj][m][0], v1 = acc[ai][bj][m][1];
            if (c0 >= C_GATE) {
#pragma unroll
              for (int j = 0; j < 4; ++j) { v0[j] = fast_sigmoid(v0[j]); v1[j] = fast_sigmoid(v1[j]); } }
            u32x4 w; w.x = pg8::cvt_pk_bf16(v0[0], v0[1]); w.y = pg8::cvt_pk_bf16(v0[2], v0[3]); w.z = pg8::cvt_pk_bf16(v1[0], v1[1]); w.w = pg8::cvt_pk_bf16(v1[2], v1[3]);
            *(u32x4*)(rowp + c0) = w; } } }
  }
};
struct EpiUp { static constexpr bool PERM = false, AFTER_DRAIN = false; bf16_t* QM; bf16_t* KM; bf16_t* VM; const float* rope;
  __device__ __forceinline__ void operator()(AccRef acc, const pg8::Unit& u, int wr, int wc, int fr, int fq) const {
    const int row0 = u.pm * 256 + wr * 64 + fr;
    if (u.aux == 0) {
      const float sc = 0.10206207261596577f * 1.4426950408889634f;
#pragma unroll
      for (int bj = 0; bj < 2; ++bj) { const int g32 = (u.pn * 256 + bj * 128 + wc * 32) >> 5;
        if (g32 < 12) { const int h = g32 / 3, part = g32 - 3 * h;
#pragma unroll
          for (int ai = 0; ai < 2; ++ai)
#pragma unroll
            for (int m = 0; m < 4; ++m) { const int r = row0 + ai * 128 + m * 16; bf16_t* dst = QM + (size_t)r * 384 + h * 96 + part * 32 + 4 * fq;
              pg8::f32x4 v0 = acc[ai][bj][m][0], v1 = acc[ai][bj][m][1];
              if (part == 2) { const f32x4 cs = *(const f32x4*)(rope + (size_t)r * 32 + 4 * fq), sn = *(const f32x4*)(rope + (size_t)r * 32 + 16 + 4 * fq);
                const pg8::f32x4 a = v0, b = v1;
#pragma unroll
                for (int j = 0; j < 4; ++j) { v0[j] = a[j] * cs[j] - b[j] * sn[j]; v1[j] = a[j] * sn[j] + b[j] * cs[j]; } }
              u32x2 w0, w1; w0.x = pg8::cvt_pk_bf16(v0[0] * sc, v0[1] * sc); w0.y = pg8::cvt_pk_bf16(v0[2] * sc, v0[3] * sc);
              w1.x = pg8::cvt_pk_bf16(v1[0] * sc, v1[1] * sc); w1.y = pg8::cvt_pk_bf16(v1[2] * sc, v1[3] * sc);
              *(u32x2*)dst = w0; *(u32x2*)(dst + 16) = w1; } } }
    } else {
#pragma unroll
      for (int bj = 0; bj < 2; ++bj) { const int h = u.pn * 2 + bj;
#pragma unroll
        for (int ai = 0; ai < 2; ++ai)
#pragma unroll
          for (int m = 0; m < 4; ++m) { const int r = row0 + ai * 128 + m * 16;
#pragma unroll
            for (int n = 0; n < 2; ++n) { const int w = wc * 32 + 16 * n + 4 * fq; const pg8::f32x4 v = acc[ai][bj][m][n];
              u32x2 o; o.x = pg8::cvt_pk_bf16(v[0], v[1]); o.y = pg8::cvt_pk_bf16(v[2], v[3]);
              if (w < 64) *(u32x2*)(KM + (size_t)r * 384 + h * 96 + w) = o; else *(u32x2*)(VM + (size_t)r * 256 + h * 64 + (w - 64)) = o; } } }
    }
  }
};
struct EpiMerge { static constexpr bool PERM = true, AFTER_DRAIN = false; const bf16_t* PROJ; float* TMP; bf16_t* MB;
  __device__ __forceinline__ void operator()(AccRef acc, const pg8::Unit& u, int wr, int wc, int fr, int fq) const {
    const int row0 = u.pm * 256 + wr * 64 + fr, n = u.aux;
#pragma unroll
    for (int ai = 0; ai < 2; ++ai)
#pragma unroll
      for (int m = 0; m < 4; ++m) { const int r = row0 + ai * 128 + m * 16;
#pragma unroll
        for (int bj = 0; bj < 2; ++bj) { const int c0 = u.pn * 256 + bj * 128 + wc * 32 + 8 * fq;
          const u32x4 gw_ = *(const u32x4*)(PROJ + (size_t)r * IN_COLS + C_GATE + n * DM + c0);
          pg8::f32x4 v0 = acc[ai][bj][m][0], v1 = acc[ai][bj][m][1];
          v0[0] *= __uint_as_float(gw_.x << 16); v0[1] *= __uint_as_float(gw_.x & 0xffff0000u); v0[2] *= __uint_as_float(gw_.y << 16); v0[3] *= __uint_as_float(gw_.y & 0xffff0000u);
          v1[0] *= __uint_as_float(gw_.z << 16); v1[1] *= __uint_as_float(gw_.z & 0xffff0000u); v1[2] *= __uint_as_float(gw_.w << 16); v1[3] *= __uint_as_float(gw_.w & 0xffff0000u);
          float* tp = TMP + (size_t)r * DM + c0;
          if (n > 0) { v0 += *(const pg8::f32x4*)tp; v1 += *(const pg8::f32x4*)(tp + 4); }
          if (n < 3) { *(pg8::f32x4*)tp = v0; *(pg8::f32x4*)(tp + 4) = v1; }
          else { u32x4 w; w.x = pg8::cvt_pk_bf16(v0[0], v0[1]); w.y = pg8::cvt_pk_bf16(v0[2], v0[3]); w.z = pg8::cvt_pk_bf16(v1[0], v1[1]); w.w = pg8::cvt_pk_bf16(v1[2], v1[3]);
            *(u32x4*)(MB + (size_t)r * DM + c0) = w; }
          asm volatile("" ::: "memory"); } }
  }
};
struct EpiRes { static constexpr bool PERM = false, AFTER_DRAIN = false; const float* res; float* T;
  __device__ __forceinline__ void operator()(AccRef acc, const pg8::Unit& u, int wr, int wc, int fr, int fq) const {
    const int row0 = u.pm * 256 + wr * 64 + fr, col0 = u.pn * 256 + wc * 32 + 4 * fq;
#pragma unroll
    for (int ai = 0; ai < 2; ++ai)
#pragma unroll
      for (int m = 0; m < 4; ++m) { const size_t off = (size_t)(row0 + ai * 128 + m * 16) * DM + col0;
#pragma unroll
        for (int bj = 0; bj < 2; ++bj)
#pragma unroll
          for (int n = 0; n < 2; ++n) { const pg8::f32x4 rv = *(const pg8::f32x4*)(res + off + bj * 128 + n * 16);
            *(pg8::f32x4*)(T + off + bj * 128 + n * 16) = rv * ALPHA + acc[ai][bj][m][n]; } }
  }
};
struct EpiBf { static constexpr bool PERM = true, AFTER_DRAIN = false; bf16_t* O; int ldc; float sc;
  __device__ __forceinline__ void operator()(AccRef acc, const pg8::Unit& u, int wr, int wc, int fr, int fq) const {
    const int row0 = u.pm * 256 + wr * 64 + fr;
#pragma unroll
    for (int ai = 0; ai < 2; ++ai)
#pragma unroll
      for (int m = 0; m < 4; ++m) { bf16_t* rowp = O + (size_t)(row0 + ai * 128 + m * 16) * ldc + u.pn * 256 + wc * 32 + 8 * fq;
#pragma unroll
        for (int bj = 0; bj < 2; ++bj) { const pg8::f32x4 v0 = acc[ai][bj][m][0] * sc, v1 = acc[ai][bj][m][1] * sc;
          u32x4 w; w.x = pg8::cvt_pk_bf16(v0[0], v0[1]); w.y = pg8::cvt_pk_bf16(v0[2], v0[3]); w.z = pg8::cvt_pk_bf16(v1[0], v1[1]); w.w = pg8::cvt_pk_bf16(v1[2], v1[3]);
          *(u32x4*)(rowp + bj * 128) = w; } }
  }
};
struct EpiSwiGLU { static constexpr bool PERM = true, AFTER_DRAIN = false; bf16_t* H; int ldh;
  __device__ __forceinline__ void operator()(AccRef acc, const pg8::Unit& u, int wr, int wc, int fr, int fq) const {
    const int row0 = u.pm * 256 + wr * 64 + fr;
#pragma unroll
    for (int ai = 0; ai < 2; ++ai)
#pragma unroll
      for (int m = 0; m < 4; ++m) { bf16_t* dst = H + (size_t)(row0 + ai * 128 + m * 16) * ldh + u.pn * 128 + wc * 32 + 8 * fq;
        float h[8];
#pragma unroll
        for (int n = 0; n < 2; ++n)
#pragma unroll
          for (int j = 0; j < 4; ++j) { const float a = acc[ai][0][m][n][j], g = acc[ai][1][m][n][j]; h[n * 4 + j] = a * fast_sigmoid(a) * g; }
        u32x4 w; w.x = pg8::cvt_pk_bf16(h[0], h[1]); w.y = pg8::cvt_pk_bf16(h[2], h[3]); w.z = pg8::cvt_pk_bf16(h[4], h[5]); w.w = pg8::cvt_pk_bf16(h[6], h[7]);
        *(u32x4*)dst = w; }
  }
};
struct EpiF32 { static constexpr bool PERM = false, AFTER_DRAIN = false; float* O;
  __device__ __forceinline__ void operator()(AccRef acc, const pg8::Unit& u, int wr, int wc, int fr, int fq) const {
    const int row0 = u.pm * 256 + wr * 64 + fr, col0 = u.pn * 256 + wc * 32 + 4 * fq;
#pragma unroll
    for (int ai = 0; ai < 2; ++ai)
#pragma unroll
      for (int m = 0; m < 4; ++m) { const size_t off = (size_t)(row0 + ai * 128 + m * 16) * DM + col0;
#pragma unroll
        for (int bj = 0; bj < 2; ++bj)
#pragma unroll
          for (int n = 0; n < 2; ++n) *(pg8::f32x4*)(O + off + bj * 128 + n * 16) = acc[ai][bj][m][n]; }
  }
};


typedef short bf16x8_t __attribute__((ext_vector_type(8)));
typedef short s16x4_t __attribute__((ext_vector_type(4)));
typedef float f32x16 __attribute__((ext_vector_type(16)));
__device__ __forceinline__ int crow(int r, int hi) { return (r & 3) + 8 * (r >> 2) + 4 * hi; }
__device__ __forceinline__ s16x4_t vtr(const LAS unsigned char* p) { return __builtin_bit_cast(s16x4_t, __builtin_amdgcn_ds_read_tr16_b64_v4i16((LAS s16x4_t*)p)); }
__device__ __forceinline__ unsigned cvtpk(float lo, float hi) { unsigned r; asm volatile("v_cvt_pk_bf16_f32 %0, %1, %2" : "=v"(r) : "v"(lo), "v"(hi)); return r; }
__device__ __forceinline__ float fmax3(float a, float b, float c) { return fmaxf(fmaxf(a, b), c); }

constexpr int MLA_KS = 208, MLA_VS = 192, MLA_KB = 64 * MLA_KS, MLA_VB = 64 * MLA_VS, MLA_COMB = 65536;
__device__ __forceinline__ void mla_unit(LAS unsigned char* lds, const bf16_t* __restrict__ QMp, const bf16_t* __restrict__ KMp, const bf16_t* __restrict__ VMp, bf16_t* __restrict__ Yp,
                                         int b, int h, int qb, int tid) {
  const int lane = tid & 63, wave = __builtin_amdgcn_readfirstlane(tid >> 6), r32 = lane & 31, hi = lane >> 5, g = wave >> 2, wq = wave & 3;
  const int q0 = qb * 128, NTL = 2 * qb + 2;
  const size_t rowbase = (size_t)b * SEQ;
  const int qrow = q0 + 32 * wq + r32;
  bf16x8_t qf[6];
  { const bf16_t* qp = QMp + ((rowbase + qrow) * 4 + h) * 96 + 8 * hi;
#pragma unroll
    for (int s = 0; s < 6; ++s) qf[s] = *(const bf16x8_t*)(qp + 16 * s); }
  f32x16 o0, o1;
#pragma unroll
  for (int i = 0; i < 16; ++i) { o0[i] = 0.f; o1[i] = 0.f; }
  float m = -1e30f, l = 0.f;
  const int kr0 = tid / 12, kc0 = tid % 12, kr1 = (tid + 512) / 12, kc1 = (tid + 512) % 12, vr = tid >> 3, vc = tid & 7;
  const unsigned char* kg0 = (const unsigned char*)KMp + ((rowbase + kr0) * 4 + h) * 192 + kc0 * 16;
  const unsigned char* kg1 = (const unsigned char*)KMp + ((rowbase + kr1) * 4 + h) * 192 + kc1 * 16;
  const unsigned char* vg = (const unsigned char*)VMp + ((rowbase + vr) * 4 + h) * 128 + vc * 16;
  const int kl0 = kr0 * MLA_KS + kc0 * 16, kl1 = kr1 * MLA_KS + kc1 * 16, vl = vr * MLA_VS + vc * 16;
  u32x4 ka, kb_, va;
  ka = *(const u32x4*)kg0; if (tid < 256) kb_ = *(const u32x4*)kg1; va = *(const u32x4*)vg;
  *(LAS u32x4*)(lds + kl0) = ka; if (tid < 256) *(LAS u32x4*)(lds + kl1) = kb_; *(LAS u32x4*)(lds + 2 * MLA_KB + vl) = va;
  __syncthreads();
  const int gi = lane & 15, g16 = lane >> 4;
  const int koff = (32 * g + r32) * MLA_KS + hi * 16;
  const int voff = (32 * g + 4 * hi + (gi >> 2)) * MLA_VS + (16 * (g16 & 1) + 4 * (gi & 3)) * 2;
  const int qmin = q0 + 32 * wq;
  for (int kt = 0; kt < NTL; ++kt) {
    const int cur = kt & 1;
    if (kt + 1 < NTL) { const size_t ko = (size_t)(kt + 1) * (64 * 768), vo = (size_t)(kt + 1) * (64 * 512);
      ka = *(const u32x4*)(kg0 + ko); if (tid < 256) kb_ = *(const u32x4*)(kg1 + ko); va = *(const u32x4*)(vg + vo); }
    const int kvb = 64 * kt + 32 * g;
    if (kvb <= qmin + 31) {
      const LAS unsigned char* kbp = lds + cur * MLA_KB + koff;
      f32x16 p;
#pragma unroll
      for (int i = 0; i < 16; ++i) p[i] = 0.f;
#pragma unroll
      for (int s = 0; s < 6; ++s) { const bf16x8_t kf = *(const LAS bf16x8_t*)(kbp + 32 * s); p = __builtin_amdgcn_mfma_f32_32x32x16_bf16(kf, qf[s], p, 0, 0, 0); }
      if (kvb + 31 > qmin) {
#pragma unroll
        for (int i = 0; i < 16; ++i) if (kvb + crow(i, hi) > qrow) p[i] = -INFINITY;
      }
      float tm = fmax3(p[0], p[1], p[2]);
#pragma unroll
      for (int i = 3; i < 15; i += 2) tm = fmax3(tm, p[i], p[i + 1]);
      tm = fmaxf(tm, p[15]);
      tm = fmaxf(tm, __shfl_xor(tm, 32));
      if (!__all(tm <= m)) { const float mn = fmaxf(m, tm), al = __builtin_amdgcn_exp2f(m - mn); l *= al; m = mn;
#pragma unroll
        for (int i = 0; i < 16; ++i) { o0[i] *= al; o1[i] *= al; } }
      float ls = 0.f;
#pragma unroll
      for (int i = 0; i < 16; ++i) { p[i] = __builtin_amdgcn_exp2f(p[i] - m); ls += p[i]; }
      l += ls;
      u32x4 pw0, pw1;
      pw0.x = cvtpk(p[0], p[1]); pw0.y = cvtpk(p[2], p[3]); pw0.z = cvtpk(p[4], p[5]); pw0.w = cvtpk(p[6], p[7]);
      pw1.x = cvtpk(p[8], p[9]); pw1.y = cvtpk(p[10], p[11]); pw1.z = cvtpk(p[12], p[13]); pw1.w = cvtpk(p[14], p[15]);
      const bf16x8_t pf0 = __builtin_bit_cast(bf16x8_t, pw0), pf1 = __builtin_bit_cast(bf16x8_t, pw1);
      const LAS unsigned char* vbp = lds + 2 * MLA_KB + cur * MLA_VB + voff;
#pragma unroll
      for (int s = 0; s < 2; ++s) {
        const s16x4_t a0 = vtr(vbp + (16 * s) * MLA_VS), a1 = vtr(vbp + (16 * s + 8) * MLA_VS);
        const s16x4_t c0 = vtr(vbp + (16 * s) * MLA_VS + 64), c1 = vtr(vbp + (16 * s + 8) * MLA_VS + 64);
        const bf16x8_t vf0 = (bf16x8_t){a0[0], a0[1], a0[2], a0[3], a1[0], a1[1], a1[2], a1[3]};
        const bf16x8_t vf1 = (bf16x8_t){c0[0], c0[1], c0[2], c0[3], c1[0], c1[1], c1[2], c1[3]};
        o0 = __builtin_amdgcn_mfma_f32_32x32x16_bf16(vf0, s ? pf1 : pf0, o0, 0, 0, 0);
        o1 = __builtin_amdgcn_mfma_f32_32x32x16_bf16(vf1, s ? pf1 : pf0, o1, 0, 0, 0);
      }
    }
    if (kt + 1 < NTL) { const int nb = cur ^ 1;
      *(LAS u32x4*)(lds + nb * MLA_KB + kl0) = ka; if (tid < 256) *(LAS u32x4*)(lds + nb * MLA_KB + kl1) = kb_; *(LAS u32x4*)(lds + 2 * MLA_KB + nb * MLA_VB + vl) = va; }
    __syncthreads();
  }
  l += __shfl_xor(l, 32);
  LAS float* cb = (LAS float*)(lds + MLA_COMB) + wq * (34 * 64) + lane;
  if (g == 1) { cb[0] = m; cb[64] = l;
#pragma unroll
    for (int i = 0; i < 16; ++i) { cb[(2 + i) * 64] = o0[i]; cb[(18 + i) * 64] = o1[i]; } }
  __syncthreads();
  if (g == 0) { const float m1 = cb[0], l1 = cb[64]; const float mt = fmaxf(m, m1), a0 = __builtin_amdgcn_exp2f(m - mt), a1 = __builtin_amdgcn_exp2f(m1 - mt);
    const float inv = 1.0f / (l * a0 + l1 * a1);
    bf16_t* yp = Yp + (rowbase + qrow) * DM + h * 64 + 4 * hi;
#pragma unroll
    for (int q4 = 0; q4 < 4; ++q4) { float v0[4], v1[4];
#pragma unroll
      for (int j = 0; j < 4; ++j) { const int i = q4 * 4 + j; v0[j] = (o0[i] * a0 + cb[(2 + i) * 64] * a1) * inv; v1[j] = (o1[i] * a0 + cb[(18 + i) * 64] * a1) * inv; }
      u32x2 w0, w1; w0.x = cvtpk(v0[0], v0[1]); w0.y = cvtpk(v0[2], v0[3]); w1.x = cvtpk(v1[0], v1[1]); w1.y = cvtpk(v1[2], v1[3]);
      *(u32x2*)(yp + 8 * q4) = w0; *(u32x2*)(yp + 32 + 8 * q4) = w1; } }
  __syncthreads();
}


constexpr int A64_KS = 144, A64_VS = 192, A64_KB = 64 * A64_KS, A64_VB = 64 * A64_VS, A64_POS = 2 * A64_KB + 2 * A64_VB, A64_BT = A64_POS + 512, A64_FLAG = A64_BT + 1024;
struct Attn64Args {
  const bf16_t* Q; int qpitch; const bf16_t* K; const bf16_t* V; int kvpitch; bf16_t* O; int opitch;
  size_t qrow0; size_t krow0;
  int qi0;
  int kt_first, n_tiles, dir;
  float scale2;
  const int* pos; float sink2;
};
template <int MODE>
__device__ __forceinline__ void attn64_unit(LAS unsigned char* lds, const Attn64Args& a, int tid) {
  const int lane = tid & 63, wave = __builtin_amdgcn_readfirstlane(tid >> 6), r32 = lane & 31, hi = lane >> 5;
  const int qi = a.qi0 + 32 * wave + r32;
  bf16x8_t qf[4];
  { const bf16_t* qp = a.Q + (a.qrow0 + 32 * wave + r32) * a.qpitch + 8 * hi;
#pragma unroll
    for (int s = 0; s < 4; ++s) qf[s] = *(const bf16x8_t*)(qp + 16 * s); }
  f32x16 o0, o1;
#pragma unroll
  for (int i = 0; i < 16; ++i) { o0[i] = 0.f; o1[i] = 0.f; }
  float m = (MODE == 1) ? a.sink2 : -1e30f, l = (MODE == 1 && hi == 0) ? 1.f : 0.f, run = 0.f;
  int pq = 0; if (MODE == 1) pq = a.pos[qi];
  const int sr = tid >> 3, sc = tid & 7;
  const bf16_t* kg = a.K + (a.krow0 + sr) * a.kvpitch + sc * 8; const bf16_t* vg = a.V + (a.krow0 + sr) * a.kvpitch + sc * 8;
  const int kl = sr * A64_KS + sc * 16, vl = sr * A64_VS + sc * 16;
  u32x4 ka, va; int pa = 0;
  { const size_t o = (size_t)a.kt_first * 64 * a.kvpitch; ka = *(const u32x4*)(kg + o); va = *(const u32x4*)(vg + o); if (MODE == 1 && tid < 64) pa = a.pos[a.kt_first * 64 + tid]; }
  *(LAS u32x4*)(lds + kl) = ka; *(LAS u32x4*)(lds + 2 * A64_KB + vl) = va; if (MODE == 1 && tid < 64) ((LAS int*)(lds + A64_POS))[tid] = pa;
  if (MODE == 2 && tid < 16) ((LAS int*)(lds + A64_FLAG))[tid] = 0;
  __syncthreads();
  const int gi = lane & 15, g16 = lane >> 4;
  const int koff = r32 * A64_KS + hi * 16;
  const int voff = (4 * hi + (gi >> 2)) * A64_VS + (16 * (g16 & 1) + 4 * (gi & 3)) * 2;
  const int qmin = a.qi0 + 32 * wave, qmax = qmin + 31;
  for (int it = 0; it < a.n_tiles; ++it) {
    const int cur = it & 1, kt = a.kt_first + it * a.dir;
    if (it + 1 < a.n_tiles) { const size_t o = (size_t)(kt + a.dir) * 64 * a.kvpitch; ka = *(const u32x4*)(kg + o); va = *(const u32x4*)(vg + o); if (MODE == 1 && tid < 64) pa = a.pos[(kt + a.dir) * 64 + tid]; }
    const int kvb = 64 * kt;
    bool active = true;
    if (MODE == 1) active = (kvb <= qmax) && (kvb + 63 >= qmin - 127);
    if (MODE == 2) active = (kvb < qmax) && !__all(run < -127.0f);
    if (active) {
      const LAS unsigned char* kbp = lds + cur * A64_KB + koff;
      f32x16 p0, p1;
#pragma unroll
      for (int i = 0; i < 16; ++i) { p0[i] = 0.f; p1[i] = 0.f; }
#pragma unroll
      for (int s = 0; s < 4; ++s) { const bf16x8_t k0 = *(const LAS bf16x8_t*)(kbp + 32 * s), k1 = *(const LAS bf16x8_t*)(kbp + 32 * A64_KS + 32 * s);
        p0 = __builtin_amdgcn_mfma_f32_32x32x16_bf16(k0, qf[s], p0, 0, 0, 0); p1 = __builtin_amdgcn_mfma_f32_32x32x16_bf16(k1, qf[s], p1, 0, 0, 0); }
      if (MODE == 2) {
        float tot[2];
#pragma unroll
        for (int blk = 1; blk >= 0; --blk) {
          f32x16& p = blk ? p1 : p0; float lb[16]; float gs[4];
#pragma unroll
          for (int i = 0; i < 16; ++i) { const float z2 = p[i] * a.scale2; const float sp = (z2 > 30.f) ? z2 : __builtin_amdgcn_logf(1.f + __builtin_amdgcn_exp2f(z2));
            const bool valid = (kvb + 32 * blk + crow(i, hi)) < qi; lb[i] = valid ? -sp : 0.f; p[i] = valid ? (z2 - sp) : -INFINITY; }
#pragma unroll
          for (int g4 = 0; g4 < 4; ++g4) gs[g4] = (lb[4 * g4] + lb[4 * g4 + 1]) + (lb[4 * g4 + 2] + lb[4 * g4 + 3]);
          float go[4];
#pragma unroll
          for (int g4 = 0; g4 < 4; ++g4) go[g4] = __shfl_xor(gs[g4], 32);
          float T[4]; float accs = 0.f;
#pragma unroll
          for (int g4 = 3; g4 >= 0; --g4) { T[g4] = accs + (hi ? 0.f : go[g4]); accs += gs[g4] + go[g4]; }
          tot[blk] = accs;
          const float base = run + (blk ? 0.f : tot[1]);
#pragma unroll
          for (int g4 = 0; g4 < 4; ++g4) { const float r3 = base + T[g4], r2 = r3 + lb[4 * g4 + 3], r1 = r2 + lb[4 * g4 + 2], r0 = r1 + lb[4 * g4 + 1];
            p[4 * g4 + 3] = __builtin_amdgcn_exp2f(p[4 * g4 + 3] + r3); p[4 * g4 + 2] = __builtin_amdgcn_exp2f(p[4 * g4 + 2] + r2);
            p[4 * g4 + 1] = __builtin_amdgcn_exp2f(p[4 * g4 + 1] + r1); p[4 * g4 + 0] = __builtin_amdgcn_exp2f(p[4 * g4 + 0] + r0); }
        }
        run += tot[0] + tot[1];
      } else {
#pragma unroll
        for (int i = 0; i < 16; ++i) { p0[i] *= a.scale2; p1[i] *= a.scale2; }
        if (MODE == 1) {
          const LAS int* sp_ = (const LAS int*)(lds + A64_POS) + cur * 64; const LAS float* bt = (const LAS float*)(lds + A64_BT);
#pragma unroll
          for (int i = 0; i < 16; ++i) { const int kvl = crow(i, hi);
            { int d = pq - sp_[kvl]; d = d < 0 ? 0 : (d > 128 ? 128 : d); const int key = kvb + kvl; p0[i] = (key <= qi && key >= qi - 127) ? p0[i] + bt[d] : -INFINITY; }
            { int d = pq - sp_[32 + kvl]; d = d < 0 ? 0 : (d > 128 ? 128 : d); const int key = kvb + 32 + kvl; p1[i] = (key <= qi && key >= qi - 127) ? p1[i] + bt[d] : -INFINITY; } }
        }
        float tm = fmax3(p0[0], p0[1], p1[0]);
#pragma unroll
        for (int i = 1; i < 16; ++i) tm = fmax3(tm, p0[i], p1[i]);
        tm = fmaxf(tm, __shfl_xor(tm, 32));
        if (!__all(tm <= m)) { const float mn = fmaxf(m, tm), al = __builtin_amdgcn_exp2f(m - mn); l *= al; m = mn;
#pragma unroll
          for (int i = 0; i < 16; ++i) { o0[i] *= al; o1[i] *= al; } }
        float ls = 0.f;
#pragma unroll
        for (int i = 0; i < 16; ++i) { p0[i] = __builtin_amdgcn_exp2f(p0[i] - m); p1[i] = __builtin_amdgcn_exp2f(p1[i] - m); ls += p0[i] + p1[i]; }
        l += ls;
      }
      u32x4 pw[4];
      pw[0].x = cvtpk(p0[0], p0[1]); pw[0].y = cvtpk(p0[2], p0[3]); pw[0].z = cvtpk(p0[4], p0[5]); pw[0].w = cvtpk(p0[6], p0[7]);
      pw[1].x = cvtpk(p0[8], p0[9]); pw[1].y = cvtpk(p0[10], p0[11]); pw[1].z = cvtpk(p0[12], p0[13]); pw[1].w = cvtpk(p0[14], p0[15]);
      pw[2].x = cvtpk(p1[0], p1[1]); pw[2].y = cvtpk(p1[2], p1[3]); pw[2].z = cvtpk(p1[4], p1[5]); pw[2].w = cvtpk(p1[6], p1[7]);
      pw[3].x = cvtpk(p1[8], p1[9]); pw[3].y = cvtpk(p1[10], p1[11]); pw[3].z = cvtpk(p1[12], p1[13]); pw[3].w = cvtpk(p1[14], p1[15]);
      const LAS unsigned char* vbp = lds + 2 * A64_KB + cur * A64_VB + voff;
#pragma unroll
      for (int s = 0; s < 4; ++s) {
        const s16x4_t a0 = vtr(vbp + (16 * s) * A64_VS), a1 = vtr(vbp + (16 * s + 8) * A64_VS);
        const s16x4_t c0 = vtr(vbp + (16 * s) * A64_VS + 64), c1 = vtr(vbp + (16 * s + 8) * A64_VS + 64);
        const bf16x8_t vf0 = (bf16x8_t){a0[0], a0[1], a0[2], a0[3], a1[0], a1[1], a1[2], a1[3]};
        const bf16x8_t vf1 = (bf16x8_t){c0[0], c0[1], c0[2], c0[3], c1[0], c1[1], c1[2], c1[3]};
        const bf16x8_t pf = __builtin_bit_cast(bf16x8_t, pw[s]);
        o0 = __builtin_amdgcn_mfma_f32_32x32x16_bf16(vf0, pf, o0, 0, 0, 0);
        o1 = __builtin_amdgcn_mfma_f32_32x32x16_bf16(vf1, pf, o1, 0, 0, 0);
      }
    }
    if (MODE == 2 && lane == 0) ((LAS int*)(lds + A64_FLAG))[cur * 8 + wave] = ((kvb < qmax) && __builtin_amdgcn_readfirstlane((int)__all(run < -127.0f))) ? 1 : 0;
    if (it + 1 < a.n_tiles) { const int nb = cur ^ 1;
      *(LAS u32x4*)(lds + nb * A64_KB + kl) = ka; *(LAS u32x4*)(lds + 2 * A64_KB + nb * A64_VB + vl) = va; if (MODE == 1 && tid < 64) ((LAS int*)(lds + A64_POS))[nb * 64 + tid] = pa; }
    __syncthreads();
    if (MODE == 2) { const LAS int* f = (const LAS int*)(lds + A64_FLAG) + cur * 8; const int all = f[0] & f[1] & f[2] & f[3] & f[4] & f[5] & f[6] & f[7];
      if (__builtin_amdgcn_readfirstlane(all)) break; }
  }
  float inv = 1.f;
  if (MODE != 2) { l += __shfl_xor(l, 32); inv = 1.0f / l; }
  bf16_t* yp = a.O + (a.qrow0 + 32 * wave + r32) * a.opitch + 4 * hi;
#pragma unroll
  for (int q4 = 0; q4 < 4; ++q4) { u32x2 w0, w1;
    w0.x = cvtpk(o0[4 * q4] * inv, o0[4 * q4 + 1] * inv); w0.y = cvtpk(o0[4 * q4 + 2] * inv, o0[4 * q4 + 3] * inv);
    w1.x = cvtpk(o1[4 * q4] * inv, o1[4 * q4 + 1] * inv); w1.y = cvtpk(o1[4 * q4 + 2] * inv, o1[4 * q4 + 3] * inv);
    *(u32x2*)(yp + 8 * q4) = w0; *(u32x2*)(yp + 32 + 8 * q4) = w1; }
  __syncthreads();
}

__device__ __forceinline__ float hgrn_forget(float fraw, float lb) { return lb + (1.f - lb) * (1.f / (1.f + __expf(-fraw))); }
__device__ __forceinline__ void hgrn_stepA(float* sm, const bf16_t* __restrict__ PROJp, const float* __restrict__ lbl, int l, float* __restrict__ HGH, float* __restrict__ HGD, float* __restrict__ HGB,
                                           int ci, int tid) {
  const int lane = tid & 63, wave = tid >> 6;
  float* sKF = sm; float* sBC = sm + 4096; float* sV = sm + 8192; float* sBL = sm + 12288;
  const int bh = ci >> 7, c = ci & 127, b = bh >> 2, h = bh & 3; const size_t row0 = (size_t)b * SEQ + c * 64;
  const int k = tid & 63;
  float lb = 0.f; if (l == 1) { const float l0 = lbl[h * 64 + k], l1 = lbl[256 + h * 64 + k]; lb = 1.f / (1.f + expf(l0 - l1)); }
#pragma unroll
  for (int j = 0; j < 8; ++j) { const int e = tid + 512 * j, s = e >> 6; const bf16_t* pr = PROJp + (row0 + s) * IN_COLS;
    const float fg = hgrn_forget(bf2f(pr[C_HF + h * 64 + k]), lb); sBC[e] = logf(fg); sKF[e] = 1.f - fg; sV[e] = bf2f(pr[C_HI + h * 64 + k]); }
  __syncthreads();
  if (wave == 0) { float run = 0.f;
    for (int s = 0; s < 64; ++s) { run += sBC[s * 64 + lane]; sBC[s * 64 + lane] = run; }
    sBL[lane] = run; HGD[(size_t)ci * 64 + lane] = expf(run); }
  __syncthreads();
  { const float bl = sBL[k];
#pragma unroll
    for (int j = 0; j < 8; ++j) { const int e = tid + 512 * j; const float bc = sBC[e]; HGB[(size_t)ci * 4096 + e] = bc; sKF[e] = sKF[e] * expf(bl - bc); } }
  __syncthreads();
  float acc[8];
#pragma unroll
  for (int i = 0; i < 8; ++i) acc[i] = 0.f;
  for (int s = 0; s < 64; ++s) { const float vv = sV[s * 64 + lane]; const f32x4 k0 = *(const f32x4*)&sKF[s * 64 + wave * 8], k1 = *(const f32x4*)&sKF[s * 64 + wave * 8 + 4];
    acc[0] += k0[0] * vv; acc[1] += k0[1] * vv; acc[2] += k0[2] * vv; acc[3] += k0[3] * vv; acc[4] += k1[0] * vv; acc[5] += k1[1] * vv; acc[6] += k1[2] * vv; acc[7] += k1[3] * vv; }
#pragma unroll
  for (int i = 0; i < 8; ++i) HGH[(size_t)ci * 4096 + (wave * 8 + i) * 64 + lane] = acc[i];
  __syncthreads();
}
__device__ __forceinline__ void hgrn_stepB(float* sm, const float* __restrict__ HGH, const float* __restrict__ HGD, float* __restrict__ HGS, int pairblk, int tid) {
  const int lane = tid & 63, wave = tid >> 6, seg = wave & 3;
  const int rowid = pairblk * 2 + (wave >> 2), bh = rowid >> 6, k = rowid & 63;
  const size_t cbase = (size_t)bh * 128 + seg * 32;
  float P = 1.f, Q = 0.f;
  for (int c = 0; c < 32; ++c) { const float d = HGD[(cbase + c) * 64 + k], hh = HGH[(cbase + c) * 4096 + k * 64 + lane]; Q = d * Q + hh; P *= d; }
  float* sP = sm + (wave >> 2) * 4; float* sQ = sm + 16 + (wave >> 2) * 256;
  sQ[seg * 64 + lane] = Q; if (lane == 0) sP[seg] = P;
  __syncthreads();
  float S = 0.f;
  for (int s2 = 0; s2 < seg; ++s2) S = sP[s2] * S + sQ[s2 * 64 + lane];
  for (int c = 0; c < 32; ++c) { const float d = HGD[(cbase + c) * 64 + k], hh = HGH[(cbase + c) * 4096 + k * 64 + lane];
    HGS[(cbase + c) * 4096 + k * 64 + lane] = S; S = d * S + hh; }
  __syncthreads();
}
__device__ __forceinline__ void hgrn_stepC(float* sm, const bf16_t* __restrict__ PROJp, const float* __restrict__ lbl, const float* __restrict__ hnorm, int l,
                                           const float* __restrict__ HGB, const float* __restrict__ HGS, bf16_t* __restrict__ Yp, int ci, int tid) {
  const int lane = tid & 63, wave = tid >> 6;
  float* sQ = sm; float* sBC = sm + 4096; float* sV = sm + 8192; float* sS = sm + 12288; float* sATT = sm + 16384; float* sKFT = sm + 20480; float* sBCT = sm + 20480 + 4160;
  const int bh = ci >> 7, c = ci & 127, b = bh >> 2, h = bh & 3; const size_t row0 = (size_t)b * SEQ + c * 64;
  const int k = tid & 63;
  float lb = 0.f; if (l == 1) { const float l0 = lbl[h * 64 + k], l1 = lbl[256 + h * 64 + k]; lb = 1.f / (1.f + expf(l0 - l1)); }
#pragma unroll
  for (int j = 0; j < 8; ++j) { const int e = tid + 512 * j, t = e >> 6; const bf16_t* pr = PROJp + (row0 + t) * IN_COLS;
    const float qv = bf2f(pr[C_HQ + h * 64 + k]); sQ[e] = qv / (1.f + __expf(-qv));
    const float bc = HGB[(size_t)ci * 4096 + e]; sBC[e] = bc; sBCT[k * 65 + t] = bc;
    sKFT[k * 65 + t] = 1.f - hgrn_forget(bf2f(pr[C_HF + h * 64 + k]), lb);
    sV[e] = bf2f(pr[C_HI + h * 64 + k]); sS[e] = HGS[(size_t)ci * 4096 + e]; }
  __syncthreads();
#pragma unroll 1
  for (int i = 0; i < 8; ++i) { const int t = wave * 8 + i; float a = 0.f;
    if (lane <= t) {
#pragma unroll 2
      for (int kk = 0; kk < 64; kk += 4) { const f32x4 q4 = *(const f32x4*)&sQ[t * 64 + kk], b4 = *(const f32x4*)&sBC[t * 64 + kk];
#pragma unroll
        for (int u = 0; u < 4; ++u) a += q4[u] * sKFT[(kk + u) * 65 + lane] * __expf(b4[u] - sBCT[(kk + u) * 65 + lane]); } }
    sATT[t * 64 + lane] = a; }
  __syncthreads();
  const float nw = hnorm[l * 256 + h * 64 + lane];
#pragma unroll 1
  for (int i = 0; i < 8; ++i) { const int t = wave * 8 + i; float o = 0.f;
#pragma unroll 2
    for (int kk = 0; kk < 64; kk += 4) { const f32x4 q4 = *(const f32x4*)&sQ[t * 64 + kk], b4 = *(const f32x4*)&sBC[t * 64 + kk];
#pragma unroll
      for (int u = 0; u < 4; ++u) o += (q4[u] * __expf(b4[u])) * sS[(kk + u) * 64 + lane]; }
#pragma unroll 4
    for (int s = 0; s <= t; ++s) o += sATT[t * 64 + s] * sV[s * 64 + lane];
    const float ms = wave_sum(o * o) * (1.f / 64.f);
    const float gv = bf2f(PROJp[(row0 + t) * IN_COLS + C_HG + h * 64 + lane]);
    Yp[(row0 + t) * DM + 512 + h * 64 + lane] = f2bf(o * rsqrtf(ms + EPS) * nw * (gv / (1.f + __expf(-gv)))); }
  __syncthreads();
}

__device__ __forceinline__ void tr_item(const float* W, int ldw, int k0, int n0, bf16_t* dst, int dst_ld, int drow0, LAS float* scr, int lane) {
#pragma unroll 8
  for (int i = 0; i < 32; ++i) { const int kk = 2 * i + (lane >> 5); scr[kk * 33 + (lane & 31)] = W[(size_t)(k0 + kk) * ldw + n0 + (lane & 31)]; }
  asm volatile("s_waitcnt lgkmcnt(0)" ::: "memory");
  const int c = lane & 7;
#pragma unroll
  for (int j = 0; j < 4; ++j) { const int n = (lane >> 3) + 8 * j; const LAS float* s = scr + (8 * c) * 33 + n;
    u32x4 o; o.x = pk2(s[0 * 33], s[1 * 33]); o.y = pk2(s[2 * 33], s[3 * 33]); o.z = pk2(s[4 * 33], s[5 * 33]); o.w = pk2(s[6 * 33], s[7 * 33]);
    *(u32x4*)(dst + (size_t)(drow0 + n) * dst_ld + k0 + 8 * c) = o; }
  asm volatile("s_waitcnt lgkmcnt(0)" ::: "memory");
}
__device__ __forceinline__ int pair_row(int c, int F) { const int g = c >= F ? 1 : 0, cc = c - g * F; return (cc >> 7) * 256 + g * 128 + (cc & 127); }

__device__ __forceinline__ void ln_rows(const float* T, float* dst, bf16_t* dstb, const float* g, const float* b, int gw, int ngw, int lane) {
  for (int r = gw; r < M; r += ngw) {
    const f32x4* tr = (const f32x4*)(T + (size_t)r * DM) + lane;
    f32x4 v[4]; float s = 0.f;
#pragma unroll
    for (int j = 0; j < 4; ++j) { v[j] = tr[64 * j]; s += (v[j][0] + v[j][1]) + (v[j][2] + v[j][3]); }
    const float mean = wave_sum(s) * (1.f / DM); float s2 = 0.f;
#pragma unroll
    for (int j = 0; j < 4; ++j) { v[j] = v[j] - mean; s2 += (v[j][0] * v[j][0] + v[j][1] * v[j][1]) + (v[j][2] * v[j][2] + v[j][3] * v[j][3]); }
    const float rstd = rsqrtf(wave_sum(s2) * (1.f / DM) + EPS);
    f32x4* o = (f32x4*)(dst + (size_t)r * DM) + lane; u32x2* ob = (u32x2*)(dstb + (size_t)r * DM) + lane;
#pragma unroll
    for (int j = 0; j < 4; ++j) { const f32x4 gg = ((const f32x4*)g)[lane + 64 * j], bb = ((const f32x4*)b)[lane + 64 * j]; const f32x4 y = v[j] * rstd * gg + bb; o[64 * j] = y;
      u32x2 w; w.x = pk2(y[0], y[1]); w.y = pk2(y[2], y[3]); ob[64 * j] = w; }
  }
}


__device__ __forceinline__ unsigned char* launder_p(unsigned char* q) { asm volatile("" : "+s"(q)); return q; }
#define ctl ((unsigned*)(ws + WS_CTL))
#define X ((float*)(ws + WS_X))
#define T ((float*)(ws + WS_T))
#define XB ((bf16_t*)(ws + WS_XB))
#define Y ((bf16_t*)(ws + WS_Y))
#define MB ((bf16_t*)(ws + WS_MB))
#define QM ((bf16_t*)(ws + WS_QM))
#define KM ((bf16_t*)(ws + WS_KM))
#define VM ((bf16_t*)(ws + WS_VM))
#define CQN ((bf16_t*)(ws + WS_CQN))
#define CKVN ((bf16_t*)(ws + WS_CKVN))
#define XQ ((bf16_t*)(ws + WS_XQ))
#define XO ((bf16_t*)(ws + WS_XO))
#define ROPE ((float*)(ws + WS_ROPE))
#define KVMEM ((bf16_t*)(ws + WS_KVMEM))
#define PROJ ((bf16_t*)(ws + WS_BIG))
#define H2 ((bf16_t*)(ws + WS_BIG))
#define YS ((float*)(ws + WS_YS))
#define XG ((bf16_t*)(ws + WS_XG))
#define tok_e ((int*)(ws + WS_ROUTE))
#define tok_p (tok_e + 2 * M)
#define tok_w ((float*)(tok_p + 2 * M))
#define tok_slot ((int*)(tok_w + 2 * M))
#define GEMM_PHASE(EpiT, SchedT, g, S, E) pg8::gemm_phase<EpiT, SchedT, true, true>(lds3, g, S, E, tid)
__global__ void __launch_bounds__(NT) mega(Params p) {
  extern __shared__ __attribute__((aligned(16))) unsigned char lds_raw[];
  float* sm = (float*)lds_raw;
  LAS unsigned char* lds30 = (LAS unsigned char*)lds_raw;
  const int G0 = gridDim.x, bid0 = blockIdx.x, wave0 = __builtin_amdgcn_readfirstlane((int)threadIdx.x >> 6);
  { LAS unsigned long long* PTAB = (LAS unsigned long long*)(lds30 + 131072 + 1024);
  if (threadIdx.x == 0) {
    PTAB[0] = (unsigned long long)(uintptr_t)p.x;
    PTAB[1] = (unsigned long long)(uintptr_t)p.mem;
    PTAB[2] = (unsigned long long)(uintptr_t)p.pos;
    PTAB[3] = (unsigned long long)(uintptr_t)p.rel;
    PTAB[4] = (unsigned long long)(uintptr_t)p.lbl;
    PTAB[5] = (unsigned long long)(uintptr_t)p.w_in;
    PTAB[6] = (unsigned long long)(uintptr_t)p.qnorm;
    PTAB[7] = (unsigned long long)(uintptr_t)p.w_uq;
    PTAB[8] = (unsigned long long)(uintptr_t)p.kvnorm;
    PTAB[9] = (unsigned long long)(uintptr_t)p.w_ukv;
    PTAB[10] = (unsigned long long)(uintptr_t)p.sinks;
    PTAB[11] = (unsigned long long)(uintptr_t)p.hnorm;
    PTAB[12] = (unsigned long long)(uintptr_t)p.w_branch;
    PTAB[13] = (unsigned long long)(uintptr_t)p.w_out;
    PTAB[14] = (unsigned long long)(uintptr_t)p.ln_g;
    PTAB[15] = (unsigned long long)(uintptr_t)p.ln_b;
    PTAB[16] = (unsigned long long)(uintptr_t)p.xa_wq;
    PTAB[17] = (unsigned long long)(uintptr_t)p.xa_wkv;
    PTAB[18] = (unsigned long long)(uintptr_t)p.xa_wo;
    PTAB[19] = (unsigned long long)(uintptr_t)p.ffn_w13;
    PTAB[20] = (unsigned long long)(uintptr_t)p.ffn_w2;
    PTAB[21] = (unsigned long long)(uintptr_t)p.router;
    PTAB[22] = (unsigned long long)(uintptr_t)p.moe_w13;
    PTAB[23] = (unsigned long long)(uintptr_t)p.moe_w2;
    PTAB[24] = (unsigned long long)(uintptr_t)p.out;
    PTAB[25] = (unsigned long long)(uintptr_t)p.ws;
  } }
  volatile LAS unsigned* MISC = (volatile LAS unsigned*)(lds30 + 131072 + 320);
  if (threadIdx.x < 32) MISC[threadIdx.x] = 0u;
  __syncthreads();
  const XcdBarrier xbar = xcd_barrier_post((unsigned*)(p.ws + WS_CTL) + CW_BAR, MISC + 8);
#define GRID_SYNC() do { PHASE_IDS xcd_barrier(xbar, tid); } while (0)
  { PHASE_IDS
    LAS float* scr = (LAS float*)(lds3 + wave * 16384);
    constexpr int I_IN = 16 * 213, I_UQ = 4 * 12, I_UKV = 2 * 16, I_BR = 4 * 32, I_OUT = 16 * 32, I_XQ = 16 * 8, I_XO = 4 * 32, I_F13 = 16 * 176, I_F2 = 44 * 32, I_M13 = 16 * 224, I_M2 = 56 * 32;
    constexpr int N_ITEMS = 2 * I_IN + 2 * I_UQ + 2 * I_UKV + 8 * I_BR + 2 * I_OUT + 2 * I_XQ + 2 * I_XO + I_F13 + I_F2 + 8 * I_M13 + 8 * I_M2;
    for (int it = gw; it < N_ITEMS; it += ngw) {
      int r = it;
      if (r < 2 * I_IN) { const int l = r / I_IN, q = r % I_IN, kb = q / 213, nb = q % 213;
        tr_item(((const float*)ptab_get(PTAB, 5)) + (size_t)l * DM * IN_COLS, IN_COLS, kb * 64, nb * 32, (bf16_t*)(ws + W_IN) + (size_t)l * IN_PAD * 1024, 1024, nb * 32, scr, lane); continue; } r -= 2 * I_IN;
      if (r < 2 * I_UQ) { const int l = r / I_UQ, q = r % I_UQ, kb = q / 12, nb = q % 12;
        tr_item(((const float*)ptab_get(PTAB, 7)) + (size_t)l * 256 * 384, 384, kb * 64, nb * 32, (bf16_t*)(ws + W_UQ) + (size_t)l * 512 * 256, 256, nb * 32, scr, lane); continue; } r -= 2 * I_UQ;
      if (r < 2 * I_UKV) { const int l = r / I_UKV, q = r % I_UKV, kb = q / 16, nb = q % 16;
        tr_item(((const float*)ptab_get(PTAB, 9)) + (size_t)l * 128 * 512, 512, kb * 64, nb * 32, (bf16_t*)(ws + W_UKV) + (size_t)l * 512 * 256, 256, nb * 32, scr, lane); continue; } r -= 2 * I_UKV;
      if (r < 8 * I_BR) { const int ln = r / I_BR, q = r % I_BR, kb = q / 32, nb = q % 32;
        tr_item(((const float*)ptab_get(PTAB, 12)) + (size_t)ln * 256 * 1024, 1024, kb * 64, nb * 32, (bf16_t*)(ws + W_BR) + (size_t)ln * 1024 * 256, 256, nb * 32, scr, lane); continue; } r -= 8 * I_BR;
      if (r < 2 * I_OUT) { const int l = r / I_OUT, q = r % I_OUT, kb = q / 32, nb = q % 32;
        tr_item(((const float*)ptab_get(PTAB, 13)) + (size_t)l * 1024 * 1024, 1024, kb * 64, nb * 32, (bf16_t*)(ws + W_OUT) + (size_t)l * 1024 * 1024, 1024, nb * 32, scr, lane); continue; } r -= 2 * I_OUT;
      if (r < 2 * I_XQ) { const int l = r / I_XQ, q = r % I_XQ, kb = q / 8, nb = q % 8;
        tr_item(((const float*)ptab_get(PTAB, 16)) + (size_t)l * 1024 * 256, 256, kb * 64, nb * 32, (bf16_t*)(ws + W_XQ) + (size_t)l * 256 * 1024, 1024, nb * 32, scr, lane); continue; } r -= 2 * I_XQ;
      if (r < 2 * I_XO) { const int l = r / I_XO, q = r % I_XO, kb = q / 32, nb = q % 32;
        tr_item(((const float*)ptab_get(PTAB, 18)) + (size_t)l * 256 * 1024, 1024, kb * 64, nb * 32, (bf16_t*)(ws + W_XO) + (size_t)l * 1024 * 256, 256, nb * 32, scr, lane); continue; } r -= 2 * I_XO;
      if (r < I_F13) { const int kb = r / 176, nb = r % 176;
        tr_item(((const float*)ptab_get(PTAB, 19)), 2 * F_DENSE, kb * 64, nb * 32, (bf16_t*)(ws + W_F13), 1024, pair_row(nb * 32, F_DENSE), scr, lane); continue; } r -= I_F13;
      if (r < I_F2) { const int kb = r / 32, nb = r % 32;
        tr_item(((const float*)ptab_get(PTAB, 20)), 1024, kb * 64, nb * 32, (bf16_t*)(ws + W_F2), F_DENSE, nb * 32, scr, lane); continue; } r -= I_F2;
      if (r < 8 * I_M13) { const int e = r / I_M13, q = r % I_M13, kb = q / 224, nb = q % 224;
        tr_item(((const float*)ptab_get(PTAB, 22)) + (size_t)e * 1024 * 2 * F_EXP, 2 * F_EXP, kb * 64, nb * 32, (bf16_t*)(ws + W_M13) + (size_t)e * 2 * F_EXP * 1024, 1024, pair_row(nb * 32, F_EXP), scr, lane); continue; } r -= 8 * I_M13;
      { const int e = r / I_M2, q = r % I_M2, kb = q / 32, nb = q % 32;
        tr_item(((const float*)ptab_get(PTAB, 23)) + (size_t)e * F_EXP * 1024, 1024, kb * 64, nb * 32, (bf16_t*)(ws + W_M2) + (size_t)e * 1024 * F_EXP, F_EXP, nb * 32, scr, lane); }
    }
    const int gt = bid * NT + tid, ngt = G * NT;
    for (int i = gt; i < 2 * 96 * 1024 / 8; i += ngt) { const int l = i / (96 * 128), q = i % (96 * 128); ((u32x4*)((bf16_t*)(ws + W_IN) + ((size_t)l * IN_PAD + IN_COLS) * 1024))[q] = (u32x4){0u, 0u, 0u, 0u}; }
    for (int i = gt; i < 2 * 128 * 256 / 8; i += ngt) { const int l = i / (128 * 32), q = i % (128 * 32); ((u32x4*)((bf16_t*)(ws + W_UQ) + ((size_t)l * 512 + 384) * 256))[q] = (u32x4){0u, 0u, 0u, 0u}; }
    for (int i = gt; i < 2 * 512 * 16; i += ngt) { const int row = i / 16, q = i % 16; ((u32x4*)((bf16_t*)(ws + W_UKV) + (size_t)row * 256 + 128))[q] = (u32x4){0u, 0u, 0u, 0u}; }
    for (int i = gt; i < M * DM / 4; i += ngt) { const f32x4 v = ((const f32x4*)((const float*)ptab_get(PTAB, 0)))[i]; u32x2 w; w.x = pk2(v[0], v[1]); w.y = pk2(v[2], v[3]); ((u32x2*)XB)[i] = w; }
  }
  cg::this_grid().sync();

  for (int l = 0; l < DEPTH; ++l) {
    { PHASE_IDS
      if (bid >= G - 16) {
        float acc[4][8], acc2[4][8];
        const float* Wkv = ((const float*)ptab_get(PTAB, 17)) + (size_t)l * DM * 512;
        const int t = bid - (G - 16), tm = t / 4, tn = t % 4;
        tile_mm<float, false>(acc, acc2, ((const float*)ptab_get(PTAB, 1)), DM, nullptr, tm * 128, Wkv, nullptr, 512, tn * 128, 512, DM, sm, tid);
#pragma unroll
        for (int i = 0; i < 4; ++i)
#pragma unroll
          for (int j = 0; j < 8; ++j) KVMEM[(size_t)(tm * 128 + ty * 4 + i) * 512 + tn * 128 + tx * 8 + j] = f2bf(acc[i][j]);
        __syncthreads();
      }
      pg8::Gemm g{1024, 1024, 1024};
      SchedGrid S{(const char*)XB, (const char*)(ws + W_IN) + (size_t)l * IN_PAD * 1024 * 2, (size_t)256 * 1024 * 2, (size_t)256 * 1024 * 2, 64, 27, G, bid};
      EpiProj E{PROJ};
      GEMM_PHASE(EpiProj, SchedGrid, g, S, E);
    }
    GRID_SYNC();
    { PHASE_IDS
      const float* qn = ((const float*)ptab_get(PTAB, 6)) + l * 256; const float* kn = ((const float*)ptab_get(PTAB, 8)) + l * 128;
      for (int r = gw; r < M; r += ngw) {
        const bf16_t* pr = PROJ + (size_t)r * IN_COLS;
        const float posf = (float)((const int*)ptab_get(PTAB, 2))[r];
        float c4[4]; float ss = 0.f;
#pragma unroll
        for (int j = 0; j < 4; ++j) { c4[j] = bf2f(pr[C_CQ + lane + 64 * j]); ss += c4[j] * c4[j]; }
        float rr = rsqrtf(wave_sum(ss) * (1.f / 256.f) + EPS);
#pragma unroll
        for (int j = 0; j < 4; ++j) CQN[(size_t)r * 256 + lane + 64 * j] = f2bf(c4[j] * rr * qn[lane + 64 * j]);
        float d2[2]; ss = 0.f;
#pragma unroll
        for (int j = 0; j < 2; ++j) { d2[j] = bf2f(pr[C_CKV + lane + 64 * j]); ss += d2[j] * d2[j]; }
        rr = rsqrtf(wave_sum(ss) * (1.f / 128.f) + EPS);
#pragma unroll
        for (int j = 0; j < 2; ++j) { CKVN[(size_t)r * 256 + lane + 64 * j] = f2bf(d2[j] * rr * kn[lane + 64 * j]); CKVN[(size_t)r * 256 + 128 + lane + 64 * j] = 0; }
        if (lane < 32) { const int i = lane & 15; const bool hi = lane >= 16; float s_, c_; sincos_big(posf * INV_FREQ[i], s_, c_);
          ROPE[(size_t)r * 32 + lane] = hi ? s_ : c_;
          const float x1 = bf2f(pr[C_KR + i]), x2 = bf2f(pr[C_KR + 16 + i]); const bf16_t v = f2bf(hi ? (x1 * s_ + x2 * c_) : (x1 * c_ - x2 * s_));
#pragma unroll
          for (int h = 0; h < 4; ++h) KM[(size_t)r * 384 + h * 96 + 64 + lane] = v; }
      }
      for (int ci = bid; ci < 1024; ci += G) hgrn_stepA(sm, PROJ, (const float*)ptab_get(PTAB, 4), l, (float*)(ws + WS_HGH), (float*)(ws + WS_HGD), (float*)(ws + WS_HGB), ci, tid);
    }
    GRID_SYNC();
    { PHASE_IDS
      for (int pb = bid; pb < 256; pb += G) hgrn_stepB(sm, (const float*)(ws + WS_HGH), (const float*)(ws + WS_HGD), (float*)(ws + WS_HGS), pb, tid);
      pg8::Gemm g{256, 256, 256};
      SchedUp S{(const char*)CQN, (const char*)(ws + W_UQ) + (size_t)l * 512 * 256 * 2, (const char*)CKVN, (const char*)(ws + W_UKV) + (size_t)l * 512 * 256 * 2, G, bid};
      EpiUp E{QM, KM, VM, ROPE};
      GEMM_PHASE(EpiUp, SchedUp, g, S, E);
    }
    GRID_SYNC();
    { PHASE_IDS
      const int vcu = (G % 8 == 0) ? (bid % 8) * (G / 8) + bid / 8 : bid;
      for (int u = vcu; u < 256; u += G) { const int bh = u >> 5, qb = u & 31, b = bh >> 2, h = bh & 3;
        { Attn64Args a; a.Q = PROJ + C_SBQ + h * 64; a.qpitch = IN_COLS; a.K = PROJ + C_SBK + h * 64; a.V = PROJ + C_SBV + h * 64; a.kvpitch = IN_COLS; a.O = Y + 768 + h * 64; a.opitch = DM;
          a.qrow0 = (size_t)b * SEQ + qb * 256; a.krow0 = (size_t)b * SEQ; a.qi0 = qb * 256; a.kt_first = 4 * qb + 3; a.n_tiles = 4 * qb + 4; a.dir = -1; a.scale2 = 0.125f * 1.4426950408889634f; a.pos = nullptr; a.sink2 = 0.f;
          attn64_unit<2>(lds3, a, tid); }
        { const int kvh = h >> 1; const float* rel = (const float*)ptab_get(PTAB, 3);
          if (tid < 129) ((LAS float*)(lds3 + A64_BT))[tid] = rel[rel_bucket(tid) * 4 + h] * 1.4426950408889634f;
          Attn64Args a; a.Q = PROJ + C_SWQ + h * 64; a.qpitch = IN_COLS; a.K = PROJ + C_SWK + kvh * 64; a.V = PROJ + C_SWV + kvh * 64; a.kvpitch = IN_COLS; a.O = Y + 256 + h * 64; a.opitch = DM;
          a.qrow0 = (size_t)b * SEQ + qb * 256; a.krow0 = (size_t)b * SEQ; a.qi0 = qb * 256; a.kt_first = qb ? 4 * qb - 2 : 0; a.n_tiles = qb ? 6 : 4; a.dir = 1; a.scale2 = 0.125f * 1.4426950408889634f;
          a.pos = (const int*)ptab_get(PTAB, 2) + (size_t)b * SEQ; a.sink2 = ((const float*)ptab_get(PTAB, 10))[l * 4 + h] * 1.4426950408889634f;
          attn64_unit<1>(lds3, a, tid); }
      }
    }
    { PHASE_IDS
      for (int ci = bid; ci < 1024; ci += G) hgrn_stepC(sm, PROJ, (const float*)ptab_get(PTAB, 4), (const float*)ptab_get(PTAB, 11), l, (const float*)(ws + WS_HGB), (const float*)(ws + WS_HGS), Y, ci, tid);
    }
    { PHASE_IDS
      const int vcu = (G % 8 == 0) ? (bid % 8) * (G / 8) + bid / 8 : bid;
      for (int pu = vcu; pu < 256; pu += G) { const int bh = pu >> 5, j = pu & 31;
        mla_unit(lds3, QM, KM, VM, Y, bh >> 2, bh & 3, 63 - j, tid);
        mla_unit(lds3, QM, KM, VM, Y, bh >> 2, bh & 3, j, tid); }
    }
    GRID_SYNC();
    { PHASE_IDS
      pg8::Gemm g{1024, 256, 256};
      SchedBranch S{(const char*)Y, (const char*)(ws + W_BR) + (size_t)l * 4 * 1024 * 256 * 2, G, bid};
      EpiMerge E{PROJ, T, MB};
      GEMM_PHASE(EpiMerge, SchedBranch, g, S, E);
    }
    GRID_SYNC();
    { PHASE_IDS
      pg8::Gemm g{1024, 1024, 1024};
      SchedGrid S{(const char*)MB, (const char*)(ws + W_OUT) + (size_t)l * 1024 * 1024 * 2, (size_t)256 * 1024 * 2, (size_t)256 * 1024 * 2, 64, 4, G, bid};
      EpiRes E{(l == 0) ? ((const float*)ptab_get(PTAB, 0)) : (const float*)X, T};
      GEMM_PHASE(EpiRes, SchedGrid, g, S, E);
    }
    GRID_SYNC();
    { PHASE_IDS ln_rows(T, X, XB, ((const float*)ptab_get(PTAB, 14)) + (l * 3 + 0) * DM, ((const float*)ptab_get(PTAB, 15)) + (l * 3 + 0) * DM, gw, ngw, lane); }
    GRID_SYNC();
    { PHASE_IDS
      pg8::Gemm g{1024, 1024, 1024};
      SchedGrid S{(const char*)XB, (const char*)(ws + W_XQ) + (size_t)l * 256 * 1024 * 2, (size_t)256 * 1024 * 2, (size_t)256 * 1024 * 2, 64, 1, G, bid};
      EpiBf E{XQ, 256, 0.125f};
      GEMM_PHASE(EpiBf, SchedGrid, g, S, E);
    }
    GRID_SYNC();
    { PHASE_IDS
      const int vcu = (G % 8 == 0) ? (bid % 8) * (G / 8) + bid / 8 : bid;
      for (int u = vcu; u < 256; u += G) { const int bh = u >> 5, qb = u & 31, b = bh >> 2, h = bh & 3;
        Attn64Args a; a.Q = XQ + h * 64; a.qpitch = 256; a.K = KVMEM + h * 64; a.V = KVMEM + 256 + h * 64; a.kvpitch = 512; a.O = XO + h * 64; a.opitch = 256;
        a.qrow0 = (size_t)b * SEQ + qb * 256; a.krow0 = (size_t)b * 256; a.qi0 = 0; a.kt_first = 0; a.n_tiles = 4; a.dir = 1; a.scale2 = 1.4426950408889634f; a.pos = nullptr; a.sink2 = 0.f;
        attn64_unit<0>(lds3, a, tid); }
    }
    GRID_SYNC();
    { PHASE_IDS
      pg8::Gemm g{256, 256, 256};
      SchedGrid S{(const char*)XO, (const char*)(ws + W_XO) + (size_t)l * 1024 * 256 * 2, (size_t)256 * 256 * 2, (size_t)256 * 256 * 2, 64, 4, G, bid};
      EpiRes E{X, T};
      GEMM_PHASE(EpiRes, SchedGrid, g, S, E);
    }
    GRID_SYNC();
    { PHASE_IDS ln_rows(T, X, XB, ((const float*)ptab_get(PTAB, 14)) + (l * 3 + 1) * DM, ((const float*)ptab_get(PTAB, 15)) + (l * 3 + 1) * DM, gw, ngw, lane); }
    GRID_SYNC();
    if (l == 0) {
      { PHASE_IDS
        pg8::Gemm g{1024, 1024, 1024};
        SchedGrid S{(const char*)XB, (const char*)(ws + W_F13), (size_t)256 * 1024 * 2, (size_t)256 * 1024 * 2, 64, 22, G, bid};
        EpiSwiGLU E{H2, F_DENSE};
        GEMM_PHASE(EpiSwiGLU, SchedGrid, g, S, E);
      }
      GRID_SYNC();
      { PHASE_IDS
        pg8::Gemm g{F_DENSE, F_DENSE, F_DENSE};
        SchedGrid S{(const char*)H2, (const char*)(ws + W_F2), (size_t)256 * F_DENSE * 2, (size_t)256 * F_DENSE * 2, 64, 4, G, bid};
        EpiRes E{X, T};
        GEMM_PHASE(EpiRes, SchedGrid, g, S, E);
      }
      GRID_SYNC();
      { PHASE_IDS ln_rows(T, X, XB, ((const float*)ptab_get(PTAB, 14)) + (l * 3 + 2) * DM, ((const float*)ptab_get(PTAB, 15)) + (l * 3 + 2) * DM, gw, ngw, lane); }
      GRID_SYNC();
    } else {
      { PHASE_IDS
        for (int r = gw; r < M; r += ngw) {
          float lg[8];
#pragma unroll
          for (int e = 0; e < 8; ++e) lg[e] = 0.f;
          for (int j = 0; j < 16; ++j) { const int k = lane + 64 * j; const float xv = X[(size_t)r * DM + k];
            const f32x4 w0 = *(const f32x4*)(((const float*)ptab_get(PTAB, 21)) + (size_t)k * 8), w1 = *(const f32x4*)(((const float*)ptab_get(PTAB, 21)) + (size_t)k * 8 + 4);
            lg[0] += xv * w0[0]; lg[1] += xv * w0[1]; lg[2] += xv * w0[2]; lg[3] += xv * w0[3]; lg[4] += xv * w1[0]; lg[5] += xv * w1[1]; lg[6] += xv * w1[2]; lg[7] += xv * w1[3]; }
#pragma unroll
          for (int e = 0; e < 8; ++e) lg[e] = wave_sum(lg[e]);
          int e0 = 0; float v0 = lg[0];
#pragma unroll
          for (int e = 1; e < 8; ++e) if (lg[e] > v0) { v0 = lg[e]; e0 = e; }
          int e1 = -1; float v1 = -3.0e38f;
#pragma unroll
          for (int e = 0; e < 8; ++e) if (e != e0 && lg[e] > v1) { v1 = lg[e]; e1 = e; }
          if (lane == 0) {
            const float w1_ = 1.f / (1.f + expf(v0 - v1)), w0_ = 1.f - w1_;
            const int p0 = (int)atomicAdd(ctl + CW_CNT + e0, 1u), p1 = (int)atomicAdd(ctl + CW_CNT + e1, 1u);
            tok_e[2 * r] = e0; tok_e[2 * r + 1] = e1; tok_p[2 * r] = p0; tok_p[2 * r + 1] = p1; tok_w[2 * r] = w0_; tok_w[2 * r + 1] = w1_;
          }
        }
      }
      GRID_SYNC();
      int pstart[9];
      { PHASE_IDS
        int cnt[8]; int a = 0;
#pragma unroll
        for (int e = 0; e < 8; ++e) { pstart[e] = a; cnt[e] = __builtin_amdgcn_readfirstlane((int)__hip_atomic_load(ctl + CW_CNT + e, __ATOMIC_RELAXED, __HIP_MEMORY_SCOPE_AGENT)); a += (cnt[e] + 255) / 256 * 256; }
        pstart[8] = a;
        for (int i = gw; i < 2 * M; i += ngw) { const int e = tok_e[i];
          int st = 0;
#pragma unroll
          for (int q = 0; q < 8; ++q) if (q == e) st = pstart[q];
          const int dest = st + tok_p[i]; if (lane == 0) tok_slot[i] = dest;
          const u32x4* src = (const u32x4*)(XB + (size_t)(i >> 1) * DM); u32x4* dst = (u32x4*)(XG + (size_t)dest * DM);
          dst[lane] = src[lane]; dst[lane + 64] = src[lane + 64]; }
        for (int e = 0; e < 8; ++e) { const int r0 = pstart[e] + cnt[e], r1 = pstart[e + 1];
          for (int rr = r0 + gw; rr < r1; rr += ngw) { u32x4* dst = (u32x4*)(XG + (size_t)rr * DM); dst[lane] = (u32x4){0u, 0u, 0u, 0u}; dst[lane + 64] = (u32x4){0u, 0u, 0u, 0u}; } }
      }
      GRID_SYNC();
      { PHASE_IDS
        pg8::Gemm g{1024, 1024, 1024};
        SchedMoE S{(const char*)XG, (const char*)(ws + W_M13), (size_t)256 * 1024 * 2, (size_t)256 * 1024 * 2, (size_t)2 * F_EXP * 1024 * 2, pstart[8] / 256, 28, G, bid,
                   pstart[1], pstart[2], pstart[3], pstart[4], pstart[5], pstart[6], pstart[7]};
        EpiSwiGLU E{H2, F_EXP};
        GEMM_PHASE(EpiSwiGLU, SchedMoE, g, S, E);
      }
      GRID_SYNC();
      { PHASE_IDS
        pg8::Gemm g{F_EXP, F_EXP, F_EXP};
        SchedMoE S{(const char*)H2, (const char*)(ws + W_M2), (size_t)256 * F_EXP * 2, (size_t)256 * F_EXP * 2, (size_t)1024 * F_EXP * 2, pstart[8] / 256, 4, G, bid,
                   pstart[1], pstart[2], pstart[3], pstart[4], pstart[5], pstart[6], pstart[7]};
        EpiF32 E{YS};
        GEMM_PHASE(EpiF32, SchedMoE, g, S, E);
      }
      GRID_SYNC();
      { PHASE_IDS
        const float* g = ((const float*)ptab_get(PTAB, 14)) + (l * 3 + 2) * DM; const float* bb_ = ((const float*)ptab_get(PTAB, 15)) + (l * 3 + 2) * DM;
        for (int r = gw; r < M; r += ngw) {
          const int s0 = tok_slot[2 * r], s1 = tok_slot[2 * r + 1]; const float w0 = tok_w[2 * r], w1 = tok_w[2 * r + 1];
          f32x4 v[4]; float s = 0.f;
#pragma unroll
          for (int j = 0; j < 4; ++j) { const f32x4 xv = ((const f32x4*)(X + (size_t)r * DM))[lane + 64 * j];
            const f32x4 y0 = ((const f32x4*)(YS + (size_t)s0 * DM))[lane + 64 * j], y1 = ((const f32x4*)(YS + (size_t)s1 * DM))[lane + 64 * j];
            v[j] = xv * ALPHA + y0 * w0 + y1 * w1; s += (v[j][0] + v[j][1]) + (v[j][2] + v[j][3]); }
          const float mean = wave_sum(s) * (1.f / DM); float s2 = 0.f;
#pragma unroll
          for (int j = 0; j < 4; ++j) { v[j] = v[j] - mean; s2 += (v[j][0] * v[j][0] + v[j][1] * v[j][1]) + (v[j][2] * v[j][2] + v[j][3] * v[j][3]); }
          const float rstd = rsqrtf(wave_sum(s2) * (1.f / DM) + EPS);
          f32x4* o = (f32x4*)(((float*)ptab_get(PTAB, 24)) + (size_t)r * DM) + lane;
#pragma unroll
          for (int j = 0; j < 4; ++j) { const f32x4 gg = ((const f32x4*)g)[lane + 64 * j], bv = ((const f32x4*)bb_)[lane + 64 * j]; o[64 * j] = v[j] * rstd * gg + bv; }
        }
      }
    }
  }
}

#undef ctl
#undef X
#undef T
#undef XB
#undef Y
#undef MB
#undef QM
#undef KM
#undef VM
#undef CQN
#undef CKVN
#undef XQ
#undef XO
#undef ROPE
#undef KVMEM
#undef PROJ
#undef H2
#undef YS
#undef XG
constexpr int LDS_BYTES = 147456;
extern "C" void kernel_launch(void* const* d_in, const int* in_sizes, int n_in, void* d_out, int out_size, void* d_ws, size_t ws_size, hipStream_t stream) {
  static int grid = 0;
  if (grid == 0) {
    int dev = 0, cus = 0, per_cu = 0;
    (void)hipGetDevice(&dev);
    (void)hipDeviceGetAttribute(&cus, hipDeviceAttributeMultiprocessorCount, dev);
    (void)hipFuncSetAttribute((const void*)mega, hipFuncAttributeMaxDynamicSharedMemorySize, LDS_BYTES);
    (void)hipOccupancyMaxActiveBlocksPerMultiprocessor(&per_cu, (const void*)mega, NT, LDS_BYTES);
    if (per_cu < 1) { fprintf(stderr, "occupancy query says %d blocks/CU\n", per_cu); per_cu = 1; }
    if (per_cu > 1) per_cu = 1;
    grid = cus * per_cu;
    if (ws_size < WS_END) { fprintf(stderr, "workspace too small: %zu < %zu\n", ws_size, (size_t)WS_END); grid = -1; }
  }
  if (grid < 0) return;
  (void)hipMemsetAsync((char*)d_ws + WS_CTL, 0, 1 * MiB, stream);
  Params p{};
  const float** f = (const float**)&p;
  for (int i = 0; i < 24; ++i) f[i] = (const float*)d_in[i];
  p.pos = (const int*)d_in[2];
  p.out = (float*)d_out; p.ws = (unsigned char*)d_ws;
  void* args[] = {&p};
  hipError_t e = hipLaunchCooperativeKernel((const void*)mega, dim3(grid), dim3(NT), args, LDS_BYTES, stream);
  if (e != hipSuccess) fprintf(stderr, "cooperative launch failed: %s (grid %d)\n", hipGetErrorString(e), grid);
}
```
